# Optimizing an MI355X kernel written in HIP

```python
import jax, jax.numpy as jnp
from jax import lax
import numpy as np

D_MODEL = 1024
BATCH = 4
SEQ = 4096
DEPTH = 2

D_MIX = D_MODEL
CONV_W = D_MIX // 4
LRU_W = (D_MIX - CONV_W) // 2
GLA_V = D_MIX - CONV_W - LRU_W
CONV_K = 31
LRU_CONV_K = 4
LRU_BLOCKS = 6
LRU_BW = LRU_W // LRU_BLOCKS
LRU_C = 8.0
GLA_HEADS = 4
GLA_DV = GLA_V // GLA_HEADS
GLA_DK = GLA_DV // 2
GLA_RANK = 16
GLA_TAU = 16.0
GLA_CHUNK = 64
IN_WIDTH = 2 * CONV_W + 2 * LRU_W + 2 * GLA_HEADS * GLA_DK + GLA_V + GLA_RANK + GLA_V
N_GROUPS = 4
EXPERTS_PER_GROUP = 4
TOP_K = 2
D_EXPERT = D_MODEL // 2
EPS = 1e-6

kernel_name = "hybrid_conv_rglru_gla_hmoe_adaln"


def rms_norm(x, g):
    xf = x.astype(jnp.float32)
    y = xf * lax.rsqrt(jnp.mean(xf * xf, axis=-1, keepdims=True) + EPS)
    return (y * g.astype(jnp.float32)).astype(x.dtype)


def layer_norm(x, g, b):
    xf = x.astype(jnp.float32)
    mu = jnp.mean(xf, axis=-1, keepdims=True)
    var = jnp.mean(jnp.square(xf - mu), axis=-1, keepdims=True)
    y = (xf - mu) * lax.rsqrt(var + EPS)
    return (y * g.astype(jnp.float32) + b.astype(jnp.float32)).astype(x.dtype)


def causal_dw_conv(x, w, b):
    k = w.shape[0]
    y = lax.conv_general_dilated(
        x, w[:, None, :].astype(x.dtype), window_strides=(1,), padding=((k - 1, 0),),
        dimension_numbers=("NWC", "WIO", "NWC"), feature_group_count=x.shape[-1])
    return y + b


def rg_lru(xb, w_a, b_a, w_i, b_i, lam):
    bsz, s, w = xb.shape
    xh = xb.reshape(bsz, s, LRU_BLOCKS, LRU_BW)
    r = jax.nn.sigmoid(jnp.einsum("bshi,hij->bshj", xh, w_a).reshape(bsz, s, w) + b_a)
    i = jax.nn.sigmoid(jnp.einsum("bshi,hij->bshj", xh, w_i).reshape(bsz, s, w) + b_i)
    log_a = -LRU_C * r.astype(jnp.float32) * jax.nn.softplus(-lam.astype(jnp.float32))
    a = jnp.exp(log_a)
    mult = jnp.sqrt(-jnp.expm1(2.0 * log_a))
    u = mult * (i * xb).astype(jnp.float32)

    def combine(left, right):
        a1, b1 = left
        a2, b2 = right
        return a1 * a2, a2 * b1 + b2

    _, h = lax.associative_scan(combine, (a, u), axis=1)
    return h.astype(xb.dtype)


def gla_chunked(q, k, v, lg):
    bsz, s, h, dk = q.shape
    n = s // GLA_CHUNK

    def chunk(t):
        return t.reshape(bsz, n, GLA_CHUNK, h, t.shape[-1]).transpose(0, 3, 1, 2, 4)

    q, k, v, lg = chunk(q) * (dk ** -0.5), chunk(k), chunk(v), chunk(lg)
    b = lax.cumsum(lg, axis=3)
    b_last = b[:, :, :, -1:, :]
    q_in = q * jnp.exp(b)
    k_in = k * jnp.exp(-b)
    mask = jnp.tril(jnp.ones((GLA_CHUNK, GLA_CHUNK), dtype=bool))
    scores = jnp.where(mask, jnp.einsum("bhncd,bhnjd->bhncj", q_in, k_in), 0.0)
    o_intra = jnp.einsum("bhncj,bhnje->bhnce", scores, v)
    kv = jnp.einsum("bhncd,bhnce->bhnde", k * jnp.exp(b_last - b), v)
    decay = jnp.exp(b_last[:, :, :, 0, :])

    def step(state, inp):
        d, kvn = inp
        return d[..., None] * state + kvn, state

    s0 = jnp.zeros((bsz, h, dk, v.shape[-1]), jnp.float32)
    _, s_prev = lax.scan(step, s0, (decay.transpose(2, 0, 1, 3), kv.transpose(2, 0, 1, 3, 4)))
    s_prev = s_prev.transpose(1, 2, 0, 3, 4)
    o = o_intra + jnp.einsum("bhncd,bhnde->bhnce", q_in, s_prev)
    return o.transpose(0, 2, 3, 1, 4).reshape(bsz, s, h, v.shape[-1])


def token_mix(h, w_in, conv_dw_w, conv_dw_b, conv_ln_g, conv_ln_b, lru_conv_w, lru_conv_b,
              lru_w_a, lru_b_a, lru_w_i, lru_b_i, lru_lam, gla_w_gate, gla_b_gate, gla_norm_g, w_out):
    bsz, s, _ = h.shape
    sizes = [CONV_W, CONV_W, LRU_W, LRU_W, GLA_HEADS * GLA_DK, GLA_HEADS * GLA_DK, GLA_V, GLA_RANK, GLA_V]
    z = h @ w_in
    cv_v, cv_g, lr_x, lr_y, q, k, v, g_lr, og = jnp.split(z, np.cumsum(sizes)[:-1].tolist(), axis=-1)
    u = cv_v * jax.nn.sigmoid(cv_g)
    u = causal_dw_conv(u, conv_dw_w, conv_dw_b)
    u = jax.nn.silu(layer_norm(u, conv_ln_g, conv_ln_b))
    r = rg_lru(causal_dw_conv(lr_x, lru_conv_w, lru_conv_b), lru_w_a, lru_b_a, lru_w_i, lru_b_i, lru_lam)
    r = r * jax.nn.gelu(lr_y)
    lg = jax.nn.log_sigmoid((g_lr @ gla_w_gate + gla_b_gate).astype(jnp.float32)) / GLA_TAU
    o = gla_chunked(q.reshape(bsz, s, GLA_HEADS, GLA_DK).astype(jnp.float32),
                    k.reshape(bsz, s, GLA_HEADS, GLA_DK).astype(jnp.float32),
                    v.reshape(bsz, s, GLA_HEADS, GLA_DV).astype(jnp.float32),
                    lg.reshape(bsz, s, GLA_HEADS, GLA_DK))
    o = rms_norm(o, gla_norm_g.reshape(GLA_HEADS, GLA_DV)).reshape(bsz, s, GLA_V).astype(h.dtype)
    o = o * jax.nn.silu(og)
    mixed = jnp.concatenate([u, r, o], axis=-1)
    return mixed @ w_out


def hier_moe(h, w_rg, b_rg, w_re, b_re, w_gate, w_up, w_down):
    hf = h.astype(jnp.float32)
    g_logits = hf @ w_rg.astype(jnp.float32) + b_rg.astype(jnp.float32)
    p_g = jax.nn.softmax(g_logits, axis=-1)
    g_star = jnp.argmax(g_logits, axis=-1)
    p_sel = jnp.take_along_axis(p_g, g_star[..., None], axis=-1)
    e_all = jnp.einsum("bsd,gde->bsge", hf, w_re.astype(jnp.float32)) + b_re.astype(jnp.float32)
    e_logits = jnp.take_along_axis(e_all, g_star[..., None, None], axis=2)[:, :, 0]
    top_v, top_i = lax.top_k(e_logits, TOP_K)
    top_w = jax.nn.softmax(top_v, axis=-1) * p_sel
    w_in_group = jnp.sum(jax.nn.one_hot(top_i, EXPERTS_PER_GROUP) * top_w[..., None], axis=-2)
    comb = (jax.nn.one_hot(g_star, N_GROUPS)[..., None] * w_in_group[..., None, :]).astype(h.dtype)
    y = jnp.zeros_like(h)
    for g in range(N_GROUPS):
        a = jnp.einsum("bsd,edf->bsef", h, w_gate[g])
        up = jnp.einsum("bsd,edf->bsef", h, w_up[g])
        hid = jax.nn.silu(a) * up * comb[:, :, g, :, None]
        y = y + jnp.einsum("bsef,efd->bsd", hid, w_down[g])
    return y


def setup_inputs(seed: int = 0) -> dict:
    key = jax.random.key(seed)
    ks = jax.random.split(key, 32)
    f32 = jnp.float32

    def nrm(k, shape, scale):
        return jax.random.normal(k, shape, f32) * scale

    L = DEPTH
    a0 = jax.random.uniform(ks[14], (L, LRU_W), f32, 0.9, 0.999)
    return {
        "x": nrm(ks[0], (BATCH, SEQ, D_MODEL), 1.0),
        "c": nrm(ks[1], (BATCH, D_MODEL), 1.0),
        "w_ada": nrm(ks[2], (L, D_MODEL, 6 * D_MODEL), 0.5 * D_MODEL ** -0.5),
        "b_ada": nrm(ks[3], (L, 6 * D_MODEL), 0.02),
        "g_mix": 1.0 + nrm(ks[4], (L, D_MODEL), 0.02),
        "w_in": nrm(ks[5], (L, D_MODEL, IN_WIDTH), D_MODEL ** -0.5),
        "conv_dw_w": nrm(ks[6], (L, CONV_K, CONV_W), CONV_K ** -0.5),
        "conv_dw_b": nrm(ks[7], (L, CONV_W), 0.02),
        "conv_ln_g": 1.0 + nrm(ks[8], (L, CONV_W), 0.02),
        "conv_ln_b": nrm(ks[9], (L, CONV_W), 0.02),
        "lru_conv_w": nrm(ks[10], (L, LRU_CONV_K, LRU_W), LRU_CONV_K ** -0.5),
        "lru_conv_b": nrm(ks[11], (L, LRU_W), 0.02),
        "lru_w_a": nrm(ks[12], (L, LRU_BLOCKS, LRU_BW, LRU_BW), LRU_BW ** -0.5),
        "lru_b_a": nrm(ks[13], (L, LRU_W), 0.02),
        "lru_w_i": nrm(ks[15], (L, LRU_BLOCKS, LRU_BW, LRU_BW), LRU_BW ** -0.5),
        "lru_b_i": nrm(ks[16], (L, LRU_W), 0.02),
        "lru_lam": jnp.log(a0) - jnp.log1p(-a0),
        "gla_w_gate": nrm(ks[17], (L, GLA_RANK, GLA_HEADS * GLA_DK), GLA_RANK ** -0.5),
        "gla_b_gate": nrm(ks[18], (L, GLA_HEADS * GLA_DK), 0.02),
        "gla_norm_g": 1.0 + nrm(ks[19], (L, GLA_V), 0.02),
        "w_out": nrm(ks[20], (L, D_MIX, D_MODEL), D_MIX ** -0.5),
        "g_ffn": 1.0 + nrm(ks[21], (L, D_MODEL), 0.02),
        "w_route_group": nrm(ks[22], (L, D_MODEL, N_GROUPS), D_MODEL ** -0.5),
        "b_route_group": nrm(ks[23], (L, N_GROUPS), 0.01),
        "w_route_expert": nrm(ks[24], (L, N_GROUPS, D_MODEL, EXPERTS_PER_GROUP), D_MODEL ** -0.5),
        "b_route_expert": nrm(ks[25], (L, N_GROUPS, EXPERTS_PER_GROUP), 0.01),
        "w_gate": nrm(ks[26], (L, N_GROUPS, EXPERTS_PER_GROUP, D_MODEL, D_EXPERT), D_MODEL ** -0.5),
        "w_up": nrm(ks[27], (L, N_GROUPS, EXPERTS_PER_GROUP, D_MODEL, D_EXPERT), D_MODEL ** -0.5),
        "w_down": nrm(ks[28], (L, N_GROUPS, EXPERTS_PER_GROUP, D_EXPERT, D_MODEL), D_EXPERT ** -0.5),
        "g_final": 1.0 + nrm(ks[29], (D_MODEL,), 0.02),
    }


def reference(x, c, w_ada, b_ada, g_mix, w_in, conv_dw_w, conv_dw_b, conv_ln_g, conv_ln_b,
              lru_conv_w, lru_conv_b, lru_w_a, lru_b_a, lru_w_i, lru_b_i, lru_lam,
              gla_w_gate, gla_b_gate, gla_norm_g, w_out, g_ffn, w_route_group, b_route_group,
              w_route_expert, b_route_expert, w_gate, w_up, w_down, g_final):
    c_act = jax.nn.silu(c)
    for l in range(DEPTH):
        mod = (c_act @ w_ada[l] + b_ada[l])[:, None, :]
        sh1, sc1, gt1, sh2, sc2, gt2 = jnp.split(mod, 6, axis=-1)
        h = rms_norm(x, g_mix[l]) * (1.0 + sc1) + sh1
        x = x + gt1 * token_mix(h, w_in[l], conv_dw_w[l], conv_dw_b[l], conv_ln_g[l], conv_ln_b[l],
                                lru_conv_w[l], lru_conv_b[l], lru_w_a[l], lru_b_a[l], lru_w_i[l],
                                lru_b_i[l], lru_lam[l], gla_w_gate[l], gla_b_gate[l], gla_norm_g[l],
                                w_out[l])
        h = rms_norm(x, g_ffn[l]) * (1.0 + sc2) + sh2
        x = x + gt2 * hier_moe(h, w_route_group[l], b_route_group[l], w_route_expert[l],
                               b_route_expert[l], w_gate[l], w_up[l], w_down[l])
    return rms_norm(x, g_final)
```

```cpp
#include <hip/hip_runtime.h>
#include <cstdio>
#include <cstdint>
namespace pg8 {
#define PG8_LAS __attribute__((address_space(3)))
typedef unsigned short bf16_t;
typedef short bf16x8 __attribute__((ext_vector_type(8)));
typedef float f32x4 __attribute__((ext_vector_type(4)));
typedef unsigned u32x4 __attribute__((ext_vector_type(4)));
constexpr int BM = 256, BK = 64, HALF = 128, HTB = HALF * BK * 2  , STAGE_BYTES = 8 * HTB, NXCD = 8, WGM = 8;

__host__ __device__ __forceinline__ int lds_byte(int r, int c) { const int st = (r >> 4) * 2 + (c >> 5), rr = r & 15, cc = c & 31, ob = rr * 64 + cc * 2; return st * 1024 + (ob ^ (((ob >> 9) & 1) << 5)); }
__host__ __device__ __forceinline__ void stage_rc(int b, int& R, int& C) { const int st = b / 1024, sb = b % 1024, swz = sb ^ (((sb >> 9) & 1) << 5); R = (st >> 1) * 16 + swz / 64; C = (st & 1) * 32 + (swz % 64) / 2; }
__host__ __device__ __forceinline__ int perm32(int rho) { const int n = rho >> 4, i = rho & 15; return 8 * (i >> 2) + 4 * n + (i & 3); }

struct Unit { int pm, pn; };
struct Gemm { const bf16_t* A; const bf16_t* Bt; int M, N, K; };

struct StaticOrder {
    int nM, nN, nwg, G, c;
    __host__ __device__ void init(int M, int N, int G_, int c_) { nM = M / BM; nN = N / BM; nwg = nM * nN; G = G_; c = c_; }
    __host__ __device__ bool next(int i, Unit& u) const {
        const long L = (long)i * G + c; if (L >= nwg) return false;
        int wgid = (int)L; { const int q = nwg / NXCD, r = nwg % NXCD, xcd = wgid % NXCD, off = wgid / NXCD; wgid = (xcd < r ? xcd * (q + 1) : r * (q + 1) + (xcd - r) * q) + off; }
        const int nig = WGM * nN, gid = wgid / nig, fm = gid * WGM, gsz = (nM - fm) < WGM ? (nM - fm) : WGM;
        u.pm = fm + ((wgid % nig) % gsz); u.pn = (wgid % nig) / gsz; return true;
    }
    __device__ __forceinline__ void a_ready(const Unit&) const {}
    __device__ __forceinline__ void done(const Unit&) const {}
};
__device__ __forceinline__ unsigned cvt_pk_bf16(float lo, float hi) { unsigned r; asm volatile("v_cvt_pk_bf16_f32 %0, %1, %2" : "=v"(r) : "v"(lo), "v"(hi)); return r; }
typedef float f32x2 __attribute__((ext_vector_type(2)));
__device__ __forceinline__ f32x2 gelu_pk(f32x2 v) {
    const f32x2 av = __builtin_elementwise_abs(v), d = av * 0.2316418882f + 1.0f;
    f32x2 t; t.x = __builtin_amdgcn_rcpf(d.x); t.y = __builtin_amdgcn_rcpf(d.y);
    f32x2 q = t * 0.5307027145f + (-0.7265760135f); q = q * t + 0.7107068705f; q = q * t + (-0.142248368f); q = q * t + 0.127414796f; q = q * t;
    const f32x2 s = (v * v) * (-0.72134752044f);
    f32x2 e; e.x = __builtin_amdgcn_exp2f(s.x); e.y = __builtin_amdgcn_exp2f(s.y);
    const f32x2 m = v * (q * e), r = v - m;
    f32x2 o; o.x = v.x < 0.f ? m.x : r.x; o.y = v.y < 0.f ? m.y : r.y; return o;
}
template <int ACT  > struct EpiBf16 {
    static constexpr bool PERM = true, AFTER_DRAIN = false; static_assert(ACT == 0 || ACT == 1, "EpiBf16: ACT is 0 (none) or 1 (gelu_pk)");
    bf16_t* O; int ldc; const float* bias; int split_cols; size_t split_stride; float scale0;
    __device__ __forceinline__ void operator()(const f32x4 (&acc)[2][2][4][2], const Unit& u, int wr, int wc, int fr, int fq) const {
        const int row0 = u.pm * BM + wr * 64 + fr; int colt = u.pn * BM; bf16_t* base = O;
        float sc = 1.f; if (split_cols) { const int t = colt / split_cols; base += (size_t)t * split_stride; colt -= t * split_cols; if (t == 0) sc = scale0; }
        const int col0 = colt + wc * 32 + 8 * fq, bcol0 = u.pn * BM + wc * 32 + 8 * fq;
        f32x4 bv[2][2];
#pragma unroll
        for (int bj = 0; bj < 2; ++bj)
#pragma unroll
            for (int n = 0; n < 2; ++n) bv[bj][n] = bias ? *(const f32x4*)(bias + bcol0 + bj * HALF + 4 * n) : (f32x4){0.f, 0.f, 0.f, 0.f};
#pragma unroll
        for (int ai = 0; ai < 2; ++ai)
#pragma unroll
            for (int m = 0; m < 4; ++m) { bf16_t* rowp = base + (size_t)(row0 + ai * HALF + m * 16) * ldc + col0;
#pragma unroll
                for (int bj = 0; bj < 2; ++bj) { f32x4 v0 = acc[ai][bj][m][0] + bv[bj][0], v1 = acc[ai][bj][m][1] + bv[bj][1];
                    if (ACT == 1) { f32x2 a = gelu_pk((f32x2){v0[0], v0[1]}), b = gelu_pk((f32x2){v0[2], v0[3]}), c = gelu_pk((f32x2){v1[0], v1[1]}), d = gelu_pk((f32x2){v1[2], v1[3]});
                        v0 = (f32x4){a.x, a.y, b.x, b.y}; v1 = (f32x4){c.x, c.y, d.x, d.y}; }
                    v0 = v0 * sc; v1 = v1 * sc; u32x4 w; w.x = cvt_pk_bf16(v0[0], v0[1]); w.y = cvt_pk_bf16(v0[2], v0[3]); w.z = cvt_pk_bf16(v1[0], v1[1]); w.w = cvt_pk_bf16(v1[2], v1[3]);
                    *(u32x4*)(rowp + bj * HALF) = w; } }
    }
};
struct GroupedOrder {
    int pre[17]; int nwg, G, c;
    __device__ __forceinline__ bool next(int i, Unit& u) const {
        const long L = (long)i * G + c; if (L >= nwg) return false;
        int wgid = (int)L; { const int q = nwg / NXCD, r = nwg % NXCD, xcd = wgid % NXCD, off = wgid / NXCD; wgid = (xcd < r ? xcd * (q + 1) : r * (q + 1) + (xcd - r) * q) + off; }
        const int mt = wgid >> 2, nt = wgid & 3; int e = 0;
#pragma unroll
        for (int k = 1; k < 16; ++k) e += (mt >= pre[k]) ? 1 : 0;
        u.pm = mt; u.pn = e * 4 + nt; return true;
    }
    __device__ __forceinline__ void a_ready(const Unit&) const {}
    __device__ __forceinline__ void done(const Unit&) const {}
};
__device__ __forceinline__ float silu_f(float v) { return v * __builtin_amdgcn_rcpf(1.0f + __expf(-v)); }
struct EpiHid {
    static constexpr bool PERM = true, AFTER_DRAIN = false;
    bf16_t* H; const float* roww;
    __device__ __forceinline__ void operator()(const f32x4 (&acc)[2][2][4][2], const Unit& u, int wr, int wc, int fr, int fq) const {
        const int row0 = u.pm * BM + wr * 64 + fr, f0 = (u.pn & 3) * 128 + wc * 32 + 8 * fq;
#pragma unroll
        for (int ai = 0; ai < 2; ++ai)
#pragma unroll
            for (int m = 0; m < 4; ++m) { const int row = row0 + ai * HALF + m * 16; const float w = roww[row];
                const f32x4 g0 = acc[ai][0][m][0], g1 = acc[ai][0][m][1], u0 = acc[ai][1][m][0], u1 = acc[ai][1][m][1];
                u32x4 o; o.x = cvt_pk_bf16(silu_f(g0[0]) * u0[0] * w, silu_f(g0[1]) * u0[1] * w); o.y = cvt_pk_bf16(silu_f(g0[2]) * u0[2] * w, silu_f(g0[3]) * u0[3] * w);
                o.z = cvt_pk_bf16(silu_f(g1[0]) * u1[0] * w, silu_f(g1[1]) * u1[1] * w); o.w = cvt_pk_bf16(silu_f(g1[2]) * u1[2] * w, silu_f(g1[3]) * u1[3] * w);
                *(u32x4*)(H + (size_t)row * 512 + f0) = o; }
    }
};
struct EpiY {
    static constexpr bool PERM = true, AFTER_DRAIN = false;
    bf16_t* Y;
    __device__ __forceinline__ void operator()(const f32x4 (&acc)[2][2][4][2], const Unit& u, int wr, int wc, int fr, int fq) const {
        const int row0 = u.pm * BM + wr * 64 + fr, col0 = (u.pn & 3) * BM + wc * 32 + 8 * fq;
#pragma unroll
        for (int ai = 0; ai < 2; ++ai)
#pragma unroll
            for (int m = 0; m < 4; ++m) { bf16_t* rowp = Y + (size_t)(row0 + ai * HALF + m * 16) * 1024 + col0;
#pragma unroll
                for (int bj = 0; bj < 2; ++bj) { const f32x4 v0 = acc[ai][bj][m][0], v1 = acc[ai][bj][m][1];
                    u32x4 w; w.x = cvt_pk_bf16(v0[0], v0[1]); w.y = cvt_pk_bf16(v0[2], v0[3]); w.z = cvt_pk_bf16(v1[0], v1[1]); w.w = cvt_pk_bf16(v1[2], v1[3]);
                    *(u32x4*)(rowp + bj * HALF) = w; } }
    }
};
struct EpiResid {
    static constexpr bool PERM = false, AFTER_DRAIN = false;
    const float* xin; float* xout; const float* gate;
    __device__ __forceinline__ void operator()(const f32x4 (&acc)[2][2][4][2], const Unit& u, int wr, int wc, int fr, int fq) const {
        const int row0 = u.pm * BM + wr * 64 + fr, col0 = u.pn * BM + wc * 32 + 4 * fq; const int b = u.pm >> 4;
        f32x4 gv[2][2];
#pragma unroll
        for (int bj = 0; bj < 2; ++bj)
#pragma unroll
            for (int n = 0; n < 2; ++n) gv[bj][n] = *(const f32x4*)(gate + (size_t)b * 6144 + col0 + bj * HALF + n * 16);
#pragma unroll
        for (int ai = 0; ai < 2; ++ai)
#pragma unroll
            for (int m = 0; m < 4; ++m) { const size_t off = (size_t)(row0 + ai * HALF + m * 16) * 1024 + col0;
#pragma unroll
                for (int bj = 0; bj < 2; ++bj)
#pragma unroll
                    for (int n = 0; n < 2; ++n) { const f32x4 xi = *(const f32x4*)(xin + off + bj * HALF + n * 16); *(f32x4*)(xout + off + bj * HALF + n * 16) = xi + gv[bj][n] * acc[ai][bj][m][n]; }
                if (m & 1) asm volatile("" ::: "memory"); }
    }
};
template <class Epi, class Sched, bool ALIGN_EPI = false, bool SP2 = false>
__device__ __forceinline__ void gemm_phase(PG8_LAS unsigned char* lds, const Gemm g, const Sched& S, const Epi& E) {
    const int tid = threadIdx.x, wid = __builtin_amdgcn_readfirstlane(tid >> 6), lane = tid & 63, wr = wid >> 2, wc = wid & 3, fr = lane & 15, fq = lane >> 4;
    const int K = g.K, nt = K / BK;
    unsigned voffA[2], voffB[2];
#pragma unroll
    for (int i = 0; i < 2; ++i) { int R, C; stage_rc(tid * 16 + i * 8192, R, C); const int Rb = Epi::PERM ? ((R & ~31) + perm32(R & 31)) : R;
        voffA[i] = (unsigned)(R * K + C) * 2u; voffB[i] = (unsigned)(Rb * K + C) * 2u; }
    const size_t kstep = (size_t)(BK * 2);
    const size_t hstep = (size_t)HALF * K * 2;
    const size_t tstep = 2 * hstep;
    const unsigned ldsw = (unsigned)wid * 1024u;
    const int aoff = lds_byte(wr * 64 + fr, fq * 8), boff = lds_byte(wc * 32 + fr, fq * 8);
#define PG8_SA(b, h) (((b) * 2 + (h)) * HTB)
#define PG8_SB(b, h) ((4 + (b) * 2 + (h)) * HTB)
#define PG8_STAGE(bufoff, gbase, voff) do { _Pragma("unroll") for (int _i = 0; _i < 2; ++_i) \
        __builtin_amdgcn_global_load_lds((const unsigned*)((const char*)(gbase) + (voff)[_i]), (PG8_LAS unsigned*)(lds + (bufoff) + ldsw + _i * 8192), 16, 0, 0); } while (0)
#define PG8_LDA(dst, b, h) do { _Pragma("unroll") for (int m = 0; m < 4; ++m) _Pragma("unroll") for (int k = 0; k < 2; ++k) dst[m][k] = *(const PG8_LAS bf16x8*)(lds + PG8_SA(b, h) + aoff + m * 2048 + k * 1024); } while (0)
#define PG8_LDB(dst, b, h) do { _Pragma("unroll") for (int n = 0; n < 2; ++n) _Pragma("unroll") for (int k = 0; k < 2; ++k) dst[n][k] = *(const PG8_LAS bf16x8*)(lds + PG8_SB(b, h) + boff + n * 2048 + k * 1024); } while (0)
#define PG8_MMA(ai, bj, At, Bt) do { __builtin_amdgcn_s_setprio(1); _Pragma("unroll") for (int m = 0; m < 4; ++m) _Pragma("unroll") for (int n = 0; n < 2; ++n) _Pragma("unroll") for (int k = 0; k < 2; ++k) \
        acc[ai][bj][m][n] = __builtin_amdgcn_mfma_f32_16x16x32_bf16(Bt[n][k], At[m][k], acc[ai][bj][m][n], 0, 0, 0); __builtin_amdgcn_s_setprio(0); } while (0)
#define PG8_WAIT_V(n) asm volatile("s_waitcnt vmcnt(" #n ")" ::: "memory")
#define PG8_WAIT_L(n) asm volatile("s_waitcnt lgkmcnt(" #n ")" ::: "memory")
#define PG8_BAR __builtin_amdgcn_s_barrier()
#define PG8_SCHED __builtin_amdgcn_sched_barrier(0)
    Unit cur, nxt; int ui = 0;
    if (!S.next(0, cur)) return;
    f32x4 acc[2][2][4][2];
#pragma unroll
    for (int a = 0; a < 2; ++a)
#pragma unroll
        for (int b = 0; b < 2; ++b)
#pragma unroll
            for (int m = 0; m < 4; ++m)
#pragma unroll
                for (int n = 0; n < 2; ++n) acc[a][b][m][n] = (f32x4){0.f, 0.f, 0.f, 0.f};
    bf16x8 At[4][2], B0[2][2], B1[2][2];
    const char* cA = (const char*)g.A + (size_t)cur.pm * tstep; const char* cB = (const char*)g.Bt + (size_t)cur.pn * tstep;
    S.a_ready(cur);
    if constexpr (SP2) {
        PG8_STAGE(PG8_SB(0, 0), cB, voffB); PG8_STAGE(PG8_SB(0, 1), cB + hstep, voffB); PG8_STAGE(PG8_SA(0, 0), cA, voffA); PG8_STAGE(PG8_SA(0, 1), cA + hstep, voffA);
        if (wr == 1) PG8_BAR;
        PG8_WAIT_V(2); PG8_BAR;
        PG8_STAGE(PG8_SB(1, 0), cB + kstep, voffB); PG8_STAGE(PG8_SA(1, 0), cA + kstep, voffA); PG8_STAGE(PG8_SB(1, 1), cB + hstep + kstep, voffB);
        PG8_WAIT_V(6); PG8_BAR;
    } else {
        PG8_STAGE(PG8_SB(0, 0), cB, voffB); PG8_STAGE(PG8_SA(0, 0), cA, voffA); PG8_STAGE(PG8_SB(0, 1), cB + hstep, voffB); PG8_STAGE(PG8_SA(0, 1), cA + hstep, voffA);
        if (wr == 1) PG8_BAR;
        PG8_WAIT_V(4); PG8_BAR;
        PG8_STAGE(PG8_SB(1, 0), cB + kstep, voffB); PG8_STAGE(PG8_SA(1, 0), cA + kstep, voffA); PG8_STAGE(PG8_SB(1, 1), cB + hstep + kstep, voffB);
        PG8_WAIT_V(6); PG8_BAR;
    }
    for (;;) {
        const bool has_next = S.next(ui + 1, nxt);
        const char* nA = has_next ? (const char*)g.A + (size_t)nxt.pm * tstep : cA; const char* nB = has_next ? (const char*)g.Bt + (size_t)nxt.pn * tstep : cB;
        for (int t = 0; t < nt; t += 2) {
            const bool last = (t == nt - 2);
            const char* a1 = cA + (size_t)(t + 1) * kstep;
            const char* a2 = last ? nA : cA + (size_t)(t + 2) * kstep; const char* b2 = last ? nB : cB + (size_t)(t + 2) * kstep;
            const char* a3 = a2 + kstep; const char* b3 = b2 + kstep;
            if (last && has_next) S.a_ready(nxt);
            if constexpr (SP2) {
            PG8_LDB(B0, 0, 0); PG8_LDB(B1, 0, 1); PG8_SCHED; PG8_LDA(At, 0, 0); PG8_STAGE(PG8_SA(1, 1), a1 + hstep, voffA);
            PG8_WAIT_V(8); PG8_WAIT_L(0); PG8_BAR; PG8_MMA(0, 0, At, B0); PG8_MMA(0, 1, At, B1); PG8_BAR; PG8_SCHED;
            PG8_LDA(At, 0, 1); PG8_STAGE(PG8_SB(0, 0), b2, voffB); PG8_STAGE(PG8_SB(0, 1), b2 + hstep, voffB); PG8_STAGE(PG8_SA(0, 0), a2, voffA);
            PG8_WAIT_V(8); PG8_WAIT_L(0); PG8_BAR; PG8_MMA(1, 0, At, B0); PG8_MMA(1, 1, At, B1); PG8_BAR; PG8_SCHED;
            PG8_LDB(B0, 1, 0); PG8_LDB(B1, 1, 1); PG8_SCHED; PG8_LDA(At, 1, 0); PG8_STAGE(PG8_SA(0, 1), a2 + hstep, voffA);
            PG8_WAIT_V(8); PG8_WAIT_L(0); PG8_BAR; PG8_MMA(0, 0, At, B0); PG8_MMA(0, 1, At, B1); PG8_BAR; PG8_SCHED;
            PG8_LDA(At, 1, 1); PG8_STAGE(PG8_SB(1, 0), b3, voffB); PG8_STAGE(PG8_SB(1, 1), b3 + hstep, voffB); PG8_STAGE(PG8_SA(1, 0), a3, voffA);
            PG8_WAIT_V(8); PG8_WAIT_L(0); PG8_BAR; PG8_MMA(1, 0, At, B0); PG8_MMA(1, 1, At, B1); PG8_BAR; PG8_SCHED;
            } else {
            PG8_LDB(B0, 0, 0); PG8_SCHED; PG8_LDA(At, 0, 0); PG8_STAGE(PG8_SA(1, 1), a1 + hstep, voffA);
            PG8_WAIT_L(8); PG8_BAR; PG8_WAIT_L(0); PG8_MMA(0, 0, At, B0); PG8_BAR; PG8_SCHED;
            PG8_LDB(B1, 0, 1); PG8_STAGE(PG8_SB(0, 0), b2, voffB);
            PG8_BAR; PG8_WAIT_L(0); PG8_MMA(0, 1, At, B1); PG8_BAR;
            PG8_LDA(At, 0, 1); PG8_STAGE(PG8_SA(0, 0), a2, voffA);
            PG8_BAR; PG8_WAIT_L(0); PG8_MMA(1, 0, At, B0); PG8_BAR; PG8_SCHED;
            PG8_STAGE(PG8_SB(0, 1), b2 + hstep, voffB);
            PG8_WAIT_V(6); PG8_BAR; PG8_MMA(1, 1, At, B1); PG8_BAR;
            PG8_LDB(B0, 1, 0); PG8_SCHED; PG8_LDA(At, 1, 0); PG8_STAGE(PG8_SA(0, 1), a2 + hstep, voffA);
            PG8_WAIT_L(8); PG8_BAR; PG8_WAIT_L(0); PG8_MMA(0, 0, At, B0); PG8_BAR; PG8_SCHED;
            PG8_LDB(B1, 1, 1); PG8_STAGE(PG8_SB(1, 0), b3, voffB);
            PG8_BAR; PG8_WAIT_L(0); PG8_MMA(0, 1, At, B1); PG8_BAR;
            PG8_LDA(At, 1, 1); PG8_STAGE(PG8_SA(1, 0), a3, voffA);
            PG8_BAR; PG8_WAIT_L(0); PG8_MMA(1, 0, At, B0); PG8_BAR; PG8_SCHED;
            PG8_STAGE(PG8_SB(1, 1), b3 + hstep, voffB);
            PG8_WAIT_V(6); PG8_BAR; PG8_MMA(1, 1, At, B1); PG8_BAR;
            }
        }
        if constexpr (ALIGN_EPI) { if (wr == 0) PG8_BAR; }
        if constexpr (!Epi::AFTER_DRAIN) { E(acc, cur, wr, wc, fr, fq); S.done(cur); }
        if (!has_next) break;
#pragma unroll
        for (int a = 0; a < 2; ++a)
#pragma unroll
            for (int b = 0; b < 2; ++b)
#pragma unroll
                for (int m = 0; m < 4; ++m)
#pragma unroll
                    for (int n = 0; n < 2; ++n) acc[a][b][m][n] = (f32x4){0.f, 0.f, 0.f, 0.f};
        cur = nxt; cA = nA; cB = nB; ++ui;
        if constexpr (ALIGN_EPI) { if (wr == 1) PG8_BAR; }
    }
    PG8_WAIT_V(0);
    if constexpr (!ALIGN_EPI) { if (wr == 0) PG8_BAR; }
    PG8_BAR;
    if constexpr (Epi::AFTER_DRAIN) { E.fused(acc, cur, wr, wc, fr, fq, lds, wid, lane); S.done(cur); }
#undef PG8_SA
#undef PG8_SB
#undef PG8_STAGE
#undef PG8_LDA
#undef PG8_LDB
#undef PG8_MMA
#undef PG8_WAIT_V
#undef PG8_WAIT_L
#undef PG8_BAR
#undef PG8_SCHED
}
}
constexpr int NWAVES = 8;
#ifndef MK_PER_PHASE
#define MK_PER_PHASE 0
#endif
#ifndef NAIVE_GEMM_MASK
#define NAIVE_GEMM_MASK 0
#endif
constexpr int T_ = 16384, D_ = 1024, S_ = 4096, INW = 2448, INP = 2560, NROWS_PAD = 36864;
constexpr float EPS_ = 1e-6f;
constexpr int ZC_CVV = 0, ZC_CVG = 256, ZC_LRX = 512, ZC_LRY = 896, ZC_Q = 1280, ZC_K = 1472, ZC_V = 1664, ZC_GLR = 2048, ZC_OG = 2064;
constexpr size_t MiB = 1u << 20;
constexpr size_t WS_CTL = 0, CTL_ZERO_BYTES = 1 * MiB;
constexpr size_t WS_MISC = 1 * MiB, MISC_STRIDE = 8 * MiB;
constexpr size_t WS_WIN = 17 * MiB, WS_WOUT = 27 * MiB, WS_WGU = 31 * MiB, WS_WD = 95 * MiB;
constexpr size_t WS_A0 = 127 * MiB;
constexpr size_t WS_A1 = 207 * MiB;
constexpr size_t WS_A2 = 243 * MiB;
constexpr size_t WS_END = 275 * MiB;
constexpr size_t MO_LRU = 262144, MO_GLA = 1310720, MO_TOKE = 6291456, MO_TOKW = 6422528, MO_TOKR = 6553600, MO_TOKP = 6684672, MO_BCNT = 6815744, MO_PRE = 6832128, MO_ROWW = 6848512;
constexpr int GLA_AGG = 48 + 48 * 96;
constexpr int CW_BAR = 4096;
constexpr int RING_BYTES = 131072, LDSCTL_OFF = 139264, MISC_OFF = LDSCTL_OFF + 320, LDS_BYTES = 147456;

#define GAS __attribute__((address_space(1)))
#define LAS __attribute__((address_space(3)))
typedef unsigned short bf16;
typedef unsigned v4u __attribute__((ext_vector_type(4)));
typedef unsigned v2u __attribute__((ext_vector_type(2)));
typedef float f32x4 __attribute__((ext_vector_type(4)));
typedef short bf16x8 __attribute__((ext_vector_type(8)));
typedef GAS unsigned gu32;
#define RLX_AGENT __ATOMIC_RELAXED, __HIP_MEMORY_SCOPE_AGENT
#define LDS_WAIT() asm volatile("s_waitcnt lgkmcnt(0)" ::: "memory")
#define VM_WAIT() asm volatile("s_waitcnt vmcnt(0)" ::: "memory")
__device__ __forceinline__ float bf2f(unsigned short h) { return __uint_as_float(((unsigned)h) << 16); }
__device__ __forceinline__ unsigned pk2(float lo, float hi) { return pg8::cvt_pk_bf16(lo, hi); }
__device__ __forceinline__ unsigned short f2bf(float f) { return (unsigned short)(pg8::cvt_pk_bf16(f, 0.f) & 0xffffu); }
__device__ __forceinline__ float lo_f(unsigned w) { return __uint_as_float(w << 16); }
__device__ __forceinline__ float hi_f(unsigned w) { return __uint_as_float(w & 0xffff0000u); }
__device__ __forceinline__ float wave_sum(float v) {
#pragma unroll
    for (int o = 1; o < 64; o <<= 1) v += __shfl_xor(v, o);
    return v;
}
__device__ __forceinline__ float sigm(float v) { return 1.0f / (1.0f + __expf(-v)); }
#define XB_TMO      128
#define XB_XCNT(j)  (256  + 64 * (j))
#define XB_XSUB(j)  (1280 + 64 * (j))
#define XB_XGEN(j)  (2304 + 64 * (j))
#define XB_TOP      3328
#define XB_TOPGEN   3392
#define XCD_BAR_WORDS 3456
#define XB_SPIN_CAP (1u << 18)

__device__ __forceinline__ unsigned xb_ld(unsigned* p)              { return __hip_atomic_load(p, __ATOMIC_RELAXED, __HIP_MEMORY_SCOPE_AGENT); }
__device__ __forceinline__ unsigned xb_add(unsigned* p, unsigned v) { return __hip_atomic_fetch_add(p, v, __ATOMIC_RELAXED, __HIP_MEMORY_SCOPE_AGENT); }
__device__ __forceinline__ unsigned xb_xcc_id() { return (unsigned)__builtin_amdgcn_s_getreg((3 << 11) | 20) & 0xFu; }
#define XB_SPIN(cond, bar) do { unsigned _sp = 0; while (cond) { __builtin_amdgcn_s_sleep(1); \
    if ((++_sp & 255u) == 0u) { if (xb_ld(&(bar)[XB_TMO])) break; if (_sp > XB_SPIN_CAP) { atomicAdd(&(bar)[XB_TMO], 1u); break; } } } } while (0)

struct XcdBarrier {
    unsigned* bar; unsigned x;
    volatile LAS unsigned* st;
};

__device__ __forceinline__ XcdBarrier xcd_barrier_post(unsigned* bar, volatile LAS unsigned* st) {
    XcdBarrier b; b.bar = bar; b.x = xb_xcc_id(); b.st = st;
    if (threadIdx.x == 0) (void)xb_add(&bar[XB_XCNT(b.x)], 1u);
    return b;
}
__device__ __forceinline__ void xcd_barrier_complete(unsigned* bar, unsigned x, unsigned& nloc, unsigned& nx) {
    const unsigned G = gridDim.x * gridDim.y * gridDim.z;
    unsigned sum, cnt, mine, sp = 0u;
    for (;;) {
        sum = 0u; cnt = 0u; mine = 0u;
#pragma unroll
        for (unsigned j = 0; j < 16; ++j) { const unsigned c = xb_ld(&bar[XB_XCNT(j)]); sum += c; cnt += (c > 0u) ? 1u : 0u; mine = (j == x) ? c : mine; }
        if (sum == G) break;
        __builtin_amdgcn_s_sleep(1);
        if ((++sp & 255u) == 0u) { if (xb_ld(&bar[XB_TMO])) break; if (sp > XB_SPIN_CAP) { atomicAdd(&bar[XB_TMO], 1u); break; } }
    }
    nloc = mine > 0u ? mine : 1u; nx = cnt > 0u ? cnt : 1u;
}

__device__ __forceinline__ void xcd_barrier(const XcdBarrier& b) {
    asm volatile("s_waitcnt vmcnt(0)" ::: "memory");
    __syncthreads();
    if (threadIdx.x == 0) {
        unsigned* bar = b.bar;
        __builtin_amdgcn_s_waitcnt(0);
        unsigned nloc = b.st[0], nx = b.st[1];
        if (nloc == 0u) { xcd_barrier_complete(bar, b.x, nloc, nx); b.st[0] = nloc; b.st[1] = nx; }
        const unsigned old = xb_add(&bar[XB_XSUB(b.x)], 1u);
        const unsigned gen = old / nloc;
        if (old + 1u == (gen + 1u) * nloc) {
            __builtin_amdgcn_fence(__ATOMIC_RELEASE, "agent");
            asm volatile("s_waitcnt vmcnt(0)" ::: "memory");
            const unsigned og = xb_add(&bar[XB_TOP], 1u);
            const unsigned tg = og / nx;
            if (og + 1u == (tg + 1u) * nx) xb_add(&bar[XB_TOPGEN], 1u);
            else XB_SPIN(xb_ld(&bar[XB_TOPGEN]) == tg, bar);
            __builtin_amdgcn_fence(__ATOMIC_ACQUIRE, "agent");
            xb_add(&bar[XB_XGEN(b.x)], 1u);
            asm volatile("s_waitcnt vmcnt(0)" ::: "memory");
        } else {
            XB_SPIN(xb_ld(&bar[XB_XGEN(b.x)]) == gen, bar);
            __builtin_amdgcn_fence(__ATOMIC_ACQUIRE, "agent");
            asm volatile("s_waitcnt vmcnt(0)" ::: "memory");
        }
    }
    __syncthreads();
}
struct Args { const float* in[30]; float* out; unsigned char* ws; int ph_lo, ph_hi, li, pad; };
struct Ctx { LAS unsigned char* lds; int tid, lane, wave, vcu, G, bx; };
__device__ __forceinline__ Ctx mkctx(LAS unsigned char* lds) {
    Ctx X; int tid = threadIdx.x; asm volatile("" : "+v"(tid)); int bx = blockIdx.x, G = gridDim.x; asm volatile("" : "+s"(bx), "+s"(G));
    X.lds = lds; X.tid = tid; X.lane = tid & 63; X.wave = __builtin_amdgcn_readfirstlane(tid >> 6); X.G = G; X.bx = bx; X.vcu = (G % 8 == 0) ? (bx % 8) * (G / 8) + bx / 8 : bx; return X;
}
#define UNIT_CTX(X0) Ctx X = (X0); { int t_ = (X0).tid; asm volatile("" : "+v"(t_)); X.tid = t_; X.lane = t_ & 63; X.wave = __builtin_amdgcn_readfirstlane(t_ >> 6); } int zo = 0; asm volatile("" : "+s"(zo))
#define AIN(i) (a.in[i] + zo)
enum { I_X = 0, I_C, I_WADA, I_BADA, I_GMIX, I_WIN, I_CDW, I_CDB, I_CLG, I_CLB, I_LCW, I_LCB, I_LWA, I_LBA, I_LWI, I_LBI, I_LAM, I_GWG, I_GBG, I_GNG, I_WOUT, I_GFFN, I_WRG, I_BRG, I_WRE, I_BRE,
       I_WG, I_WU, I_WDN, I_GFIN };
#define WSP(T, off) ((T*)(a.ws + zo + (off)))
#define MISCP(T, l, off) ((T*)(a.ws + zo + WS_MISC + (size_t)(l) * MISC_STRIDE + (off)))
#define MODP(a) ((float*)((a).ws + zo + WS_MISC))
#define BSYNC() __syncthreads()

__device__ __forceinline__ void transpose_item(const float* W, int N, int k0, int n0, bf16* WT, int ldk, int dst_row0, LAS float* scr, int lane) {
    const int kq = lane >> 4, n4 = (lane & 15) * 4;
    f32x4 v[16];
#pragma unroll
    for (int i = 0; i < 16; ++i) { const int k = 4 * i + kq; v[i] = (n0 + n4 < N) ? *(const f32x4*)(W + (size_t)(k0 + k) * N + n0 + n4) : (f32x4){0.f, 0.f, 0.f, 0.f}; }
#pragma unroll
    for (int i = 0; i < 16; ++i) { const int k = 4 * i + kq; LAS float* s = scr + k * 65 + n4; s[0] = v[i].x; s[1] = v[i].y; s[2] = v[i].z; s[3] = v[i].w; }
    LDS_WAIT(); asm volatile("" ::: "memory");
    const int c = lane & 7;
#pragma unroll
    for (int j = 0; j < 8; ++j) { const int n = (lane >> 3) + 8 * j; const LAS float* s = scr + (8 * c) * 65 + n;
        v4u o; o.x = pk2(s[0], s[65]); o.y = pk2(s[130], s[195]); o.z = pk2(s[260], s[325]); o.w = pk2(s[390], s[455]);
        *(v4u*)(WT + (size_t)(dst_row0 + n) * ldk + k0 + 8 * c) = o; }
    LDS_WAIT(); asm volatile("" ::: "memory");
}
__device__ __forceinline__ void p0_prologue(const Args& a, const Ctx& X) {
    const int zo = 0;
    for (int u = X.vcu; u < 192; u += X.G) {
        const int l = u / 96, n0 = (u % 96) * 64;
        LAS float* cact = (LAS float*)(X.lds); LAS float* red = (LAS float*)(X.lds + 16384);
        for (int i = X.tid; i < 4096; i += 512) { const float v = a.in[I_C][i]; cact[i] = v * sigm(v); }
        BSYNC();
        const int cq = X.tid & 15, kc = X.tid >> 4;
        f32x4 acc[4] = {{0.f, 0.f, 0.f, 0.f}, {0.f, 0.f, 0.f, 0.f}, {0.f, 0.f, 0.f, 0.f}, {0.f, 0.f, 0.f, 0.f}};
        const float* wp = a.in[I_WADA] + ((size_t)l * 1024 + kc * 32) * 6144 + n0 + cq * 4;
#pragma unroll 8
        for (int kk = 0; kk < 32; ++kk) { const f32x4 w = *(const f32x4*)(wp + (size_t)kk * 6144);
#pragma unroll
            for (int b = 0; b < 4; ++b) acc[b] += w * cact[b * 1024 + kc * 32 + kk]; }
#pragma unroll
        for (int b = 0; b < 4; ++b) *(LAS f32x4*)(red + (kc * 4 + b) * 64 + cq * 4) = acc[b];
        BSYNC();
        if (X.tid < 256) { const int b = X.tid >> 6, col = X.tid & 63; float s = 0.f;
            for (int k2 = 0; k2 < 32; ++k2) s += red[(k2 * 4 + b) * 64 + col];
            MODP(a)[(size_t)(l * 4 + b) * 6144 + n0 + col] = s + a.in[I_BADA][l * 6144 + n0 + col]; }
        BSYNC();
    }
    LAS float* scr = (LAS float*)(X.lds + X.wave * 16640);
    const int gw = X.vcu * NWAVES + X.wave, NGW = X.G * NWAVES;
    constexpr int NI_IN = 2 * 16 * 40, NI_OUT = 2 * 16 * 16, NI_E = 32 * 128;
    for (int it = gw; it < NI_IN + NI_OUT + 3 * NI_E; it += NGW) {
        int r = it;
        if (r < NI_IN) { const int l = r / 640; r %= 640; const int kt = r / 40, nt = r % 40;
            transpose_item(a.in[I_WIN] + (size_t)l * 1024 * INW, INW, kt * 64, nt * 64, WSP(bf16, WS_WIN) + (size_t)l * INP * 1024, 1024, nt * 64, scr, X.lane); continue; }
        r -= NI_IN;
        if (r < NI_OUT) { const int l = r / 256; r %= 256; const int kt = r / 16, nt = r % 16;
            transpose_item(a.in[I_WOUT] + (size_t)l * 1048576, 1024, kt * 64, nt * 64, WSP(bf16, WS_WOUT) + (size_t)l * 1048576, 1024, nt * 64, scr, X.lane); continue; }
        r -= NI_OUT;
        if (r < NI_E) { const int le = r / 128; r %= 128; const int kt = r / 8, n0 = (r % 8) * 64;
            transpose_item(a.in[I_WG] + (size_t)le * 524288, 512, kt * 64, n0, WSP(bf16, WS_WGU) + (size_t)le * 1048576, 1024, (n0 >> 7) * 256 + (n0 & 127), scr, X.lane); continue; }
        r -= NI_E;
        if (r < NI_E) { const int le = r / 128; r %= 128; const int kt = r / 8, n0 = (r % 8) * 64;
            transpose_item(a.in[I_WU] + (size_t)le * 524288, 512, kt * 64, n0, WSP(bf16, WS_WGU) + (size_t)le * 1048576, 1024, (n0 >> 7) * 256 + 128 + (n0 & 127), scr, X.lane); continue; }
        r -= NI_E;
        { const int le = r / 128; r %= 128; const int kt = r / 16, nt = r % 16;
            transpose_item(a.in[I_WDN] + (size_t)le * 524288, 1024, kt * 64, nt * 64, WSP(bf16, WS_WD) + (size_t)le * 524288, 512, nt * 64, scr, X.lane); }
    }
}

template <int MODE> __device__ __forceinline__ void row_phase(const Args& a, const Ctx& X, int l) {
    const int zo = 0;
    const int gw = X.vcu * NWAVES + X.wave, NGW = X.G * NWAVES;
    const int lp = (MODE == 2) ? 1 : l - 1;
    const float* xin = (MODE == 0) ? a.in[I_X] : a.out;
    const bf16* Y = WSP(bf16, WS_A0); bf16* H = WSP(bf16, WS_A2);
    for (int m = gw; m < T_; m += NGW) {
        const int b = m >> 12;
        f32x4 v[4];
#pragma unroll
        for (int j = 0; j < 4; ++j) v[j] = ((const f32x4*)(xin + (size_t)m * 1024))[X.lane + 64 * j];
        if (MODE >= 1) {
            const int* tp = MISCP(int, lp, MO_TOKP); const int p0 = tp[2 * m], p1 = tp[2 * m + 1];
            const float* gt = MODP(a) + ((size_t)(lp * 4 + b) * 6 + 5) * 1024;
#pragma unroll
            for (int j = 0; j < 4; ++j) { const v2u y0 = ((const v2u*)(Y + (size_t)p0 * 1024))[X.lane + 64 * j], y1 = ((const v2u*)(Y + (size_t)p1 * 1024))[X.lane + 64 * j];
                const f32x4 g = ((const f32x4*)gt)[X.lane + 64 * j];
                const f32x4 ys = {lo_f(y0.x) + lo_f(y1.x), hi_f(y0.x) + hi_f(y1.x), lo_f(y0.y) + lo_f(y1.y), hi_f(y0.y) + hi_f(y1.y)};
                v[j] += g * ys; }
            if (MODE == 1) {
#pragma unroll
                for (int j = 0; j < 4; ++j) ((f32x4*)(a.out + (size_t)m * 1024))[X.lane + 64 * j] = v[j]; }
        }
        float ss = 0.f;
#pragma unroll
        for (int j = 0; j < 4; ++j) ss += (v[j].x * v[j].x + v[j].y * v[j].y) + (v[j].z * v[j].z + v[j].w * v[j].w);
        const float rstd = 1.0f / sqrtf(wave_sum(ss) * (1.0f / 1024.0f) + EPS_);
        if (MODE == 2) {
#pragma unroll
            for (int j = 0; j < 4; ++j) { const f32x4 g = ((const f32x4*)a.in[I_GFIN])[X.lane + 64 * j]; ((f32x4*)(a.out + (size_t)m * 1024))[X.lane + 64 * j] = v[j] * rstd * g; }
        } else {
            const float* md = MODP(a) + (size_t)(l * 4 + b) * 6144;
#pragma unroll
            for (int j = 0; j < 4; ++j) { const f32x4 g = ((const f32x4*)(a.in[I_GMIX] + l * 1024))[X.lane + 64 * j], sh = ((const f32x4*)md)[X.lane + 64 * j], sc = ((const f32x4*)(md + 1024))[X.lane + 64 * j];
                const f32x4 h = v[j] * rstd * g * (sc + 1.0f) + sh;
                v2u o; o.x = pk2(h.x, h.y); o.y = pk2(h.z, h.w); ((v2u*)(H + (size_t)m * 1024))[X.lane + 64 * j] = o; }
        }
    }
}

__device__ __forceinline__ void conv_unit(const Args& a, const Ctx& X0, int l, int u) {
    UNIT_CTX(X0);
    const int b = u >> 6, t0 = (u & 63) * 64; const size_t m0 = (size_t)u * 64;
    const bf16* Z = WSP(bf16, WS_A0); bf16* MX = WSP(bf16, WS_A1);
    LAS float* U = (LAS float*)X.lds;
    for (int idx = X.tid; idx < 94 * 32; idx += 512) {
        const int r = idx >> 5, c8 = (idx & 31) * 8, t = t0 - 30 + r;
        f32x4 o0 = {0.f, 0.f, 0.f, 0.f}, o1 = {0.f, 0.f, 0.f, 0.f};
        if (t >= 0) { const bf16* zr = Z + ((size_t)b * S_ + t) * INP; const v4u vv = *(const v4u*)(zr + ZC_CVV + c8), gg = *(const v4u*)(zr + ZC_CVG + c8);
            o0.x = lo_f(vv.x) * sigm(lo_f(gg.x)); o0.y = hi_f(vv.x) * sigm(hi_f(gg.x)); o0.z = lo_f(vv.y) * sigm(lo_f(gg.y)); o0.w = hi_f(vv.y) * sigm(hi_f(gg.y));
            o1.x = lo_f(vv.z) * sigm(lo_f(gg.z)); o1.y = hi_f(vv.z) * sigm(hi_f(gg.z)); o1.z = lo_f(vv.w) * sigm(lo_f(gg.w)); o1.w = hi_f(vv.w) * sigm(hi_f(gg.w)); }
        *(LAS f32x4*)(U + r * 256 + c8) = o0; *(LAS f32x4*)(U + r * 256 + c8 + 4) = o1;
    }
    BSYNC();
    const int c = X.tid & 255, half = X.tid >> 8;
    float outv[32];
    {
        float wgt[31];
#pragma unroll
        for (int j = 0; j < 31; ++j) wgt[j] = AIN(I_CDW)[(l * 31 + j) * 256 + c];
        const float bias = AIN(I_CDB)[l * 256 + c];
#pragma unroll
        for (int g = 0; g < 4; ++g) {
            float win[38];
#pragma unroll
            for (int i = 0; i < 38; ++i) win[i] = U[(half * 32 + g * 8 + i) * 256 + c];
#pragma unroll
            for (int o = 0; o < 8; ++o) { float s = bias;
#pragma unroll
                for (int j = 0; j < 31; ++j) s += wgt[j] * win[o + j];
                outv[g * 8 + o] = s; }
        }
    }
    BSYNC();
#pragma unroll
    for (int i = 0; i < 32; ++i) U[(half * 32 + i) * 256 + c] = outv[i];
    BSYNC();
    {
        const f32x4 g = ((const f32x4*)(AIN(I_CLG) + l * 256))[X.lane], be = ((const f32x4*)(AIN(I_CLB) + l * 256))[X.lane];
        for (int i = 0; i < 8; ++i) { const int t = X.wave * 8 + i;
            const f32x4 v = *(LAS f32x4*)(U + t * 256 + X.lane * 4);
            const float mu = wave_sum((v.x + v.y) + (v.z + v.w)) * (1.0f / 256.0f);
            const f32x4 d = v - mu;
            const float var = wave_sum((d.x * d.x + d.y * d.y) + (d.z * d.z + d.w * d.w)) * (1.0f / 256.0f);
            const float rstd = 1.0f / sqrtf(var + EPS_);
            f32x4 y = d * rstd * g + be;
            y.x *= sigm(y.x); y.y *= sigm(y.y); y.z *= sigm(y.z); y.w *= sigm(y.w);
            v2u o; o.x = pk2(y.x, y.y); o.y = pk2(y.z, y.w);
            *(v2u*)(MX + (m0 + t) * 1024 + X.lane * 4) = o; }
    }
}

__device__ __forceinline__ float gelu_tanh(float v) { const float t = 0.7978845608f * (v + 0.044715f * v * v * v); const float e = __expf(2.0f * t); const float th = 1.0f - 2.0f / (e + 1.0f); return 0.5f * v * (1.0f + th); }
template <bool FULL> __device__ __forceinline__ void lru_unit(const Args& a, const Ctx& X0, int l, int u) {
    UNIT_CTX(X0);
    const int b = u >> 6, tile = u & 63, t0 = tile * 64; const size_t m0 = (size_t)u * 64;
    const bf16* Z = WSP(bf16, WS_A0); bf16* MX = WSP(bf16, WS_A1);
    float* AGG = MISCP(float, l, MO_LRU);
    LAS bf16* XB = (LAS bf16*)X.lds;
    LAS float* As = (LAS float*)(X.lds + 51200 + X.wave * 8192);
    LAS float* Us = As + 1024;
    LAS float* CIN = (LAS float*)(X.lds + 51200 + 65536);
    for (int idx = X.tid; idx < 64 * 48; idx += 512) {
        const int t = idx / 48, c = (idx % 48) * 8;
        float acc[8];
#pragma unroll
        for (int i = 0; i < 8; ++i) acc[i] = AIN(I_LCB)[l * 384 + c + i];
#pragma unroll
        for (int k = 0; k < 4; ++k) { const int tt = t0 + t - 3 + k;
            if (tt >= 0) { const v4u xv = *(const v4u*)(Z + ((size_t)b * S_ + tt) * INP + ZC_LRX + c);
                const f32x4 w0 = *(const f32x4*)(AIN(I_LCW) + (l * 4 + k) * 384 + c), w1 = *(const f32x4*)(AIN(I_LCW) + (l * 4 + k) * 384 + c + 4);
                acc[0] += w0.x * lo_f(xv.x); acc[1] += w0.y * hi_f(xv.x); acc[2] += w0.z * lo_f(xv.y); acc[3] += w0.w * hi_f(xv.y);
                acc[4] += w1.x * lo_f(xv.z); acc[5] += w1.y * hi_f(xv.z); acc[6] += w1.z * lo_f(xv.w); acc[7] += w1.w * hi_f(xv.w); } }
        v4u o; o.x = pk2(acc[0], acc[1]); o.y = pk2(acc[2], acc[3]); o.z = pk2(acc[4], acc[5]); o.w = pk2(acc[6], acc[7]);
        *(LAS v4u*)(XB + t * 392 + c) = o;
    }
    if (FULL && X.tid < 384) { float cr = 0.f;
        for (int j = 0; j < tile; ++j) { const float2 ph = *(const float2*)(AGG + ((size_t)(b * 64 + j) * 384 + X.tid) * 2); cr = ph.x * cr + ph.y; }
        CIN[X.tid] = cr; }
    BSYNC();
    const int col = X.lane & 15, q = X.lane >> 4;
    for (int it = X.wave; it < 24; it += 8) {
        const int h = it >> 2, jt = it & 3, c = h * 64 + jt * 16 + col;
        bf16x8 fa[2], fi[2];
#pragma unroll
        for (int ks = 0; ks < 2; ++ks)
#pragma unroll
            for (int jj = 0; jj < 8; ++jj) { const size_t wi = ((size_t)(l * 6 + h) * 64 + ks * 32 + 8 * q + jj) * 64 + jt * 16 + col;
                fa[ks][jj] = (short)f2bf(AIN(I_LWA)[wi]); fi[ks][jj] = (short)f2bf(AIN(I_LWI)[wi]); }
        f32x4 accA[4], accI[4];
#pragma unroll
        for (int tt = 0; tt < 4; ++tt) { accA[tt] = (f32x4){0.f, 0.f, 0.f, 0.f}; accI[tt] = (f32x4){0.f, 0.f, 0.f, 0.f};
#pragma unroll
            for (int ks = 0; ks < 2; ++ks) { const bf16x8 av = *(const LAS bf16x8*)(XB + (tt * 16 + col) * 392 + h * 64 + ks * 32 + 8 * q);
                accA[tt] = __builtin_amdgcn_mfma_f32_16x16x32_bf16(av, fa[ks], accA[tt], 0, 0, 0);
                accI[tt] = __builtin_amdgcn_mfma_f32_16x16x32_bf16(av, fi[ks], accI[tt], 0, 0, 0); } }
        const float ba = AIN(I_LBA)[l * 384 + c], bi = AIN(I_LBI)[l * 384 + c];
        const float lam = AIN(I_LAM)[l * 384 + c];
        const float sp = (lam > 15.f) ? __expf(-lam) : log1pf(__expf(-lam));
#pragma unroll
        for (int tt = 0; tt < 4; ++tt)
#pragma unroll
            for (int r = 0; r < 4; ++r) { const int t = tt * 16 + 4 * q + r;
                const float rg = sigm(accA[tt][r] + ba), ig = sigm(accI[tt][r] + bi);
                const float la = -8.0f * rg * sp, av = __expf(la), mult = sqrtf(-expm1f(2.0f * la));
                const float xb = bf2f(XB[t * 392 + c]);
                As[t * 16 + col] = av; Us[t * 16 + col] = mult * (ig * xb); }
        LDS_WAIT(); asm volatile("" ::: "memory");
        float P = 1.f, Hh = 0.f;
#pragma unroll
        for (int s = 0; s < 16; ++s) { const float av = As[(16 * q + s) * 16 + col], uv = Us[(16 * q + s) * 16 + col]; Hh = av * Hh + uv; P *= av; }
        const float P0 = __shfl(P, col), H0 = __shfl(Hh, col), P1 = __shfl(P, col + 16), H1 = __shfl(Hh, col + 16), P2 = __shfl(P, col + 32), H2 = __shfl(Hh, col + 32), P3 = __shfl(P, col + 48), H3 = __shfl(Hh, col + 48);
        const float c0 = FULL ? CIN[c] : 0.f;
        const float c1 = P0 * c0 + H0, c2 = P1 * c1 + H1, c3 = P2 * c2 + H2, cend = P3 * c3 + H3;
        if (!FULL) { if (q == 0) *(float2*)(AGG + ((size_t)u * 384 + c) * 2) = make_float2(P0 * P1 * P2 * P3, cend); }
        else { float hh = (q == 0) ? c0 : (q == 1) ? c1 : (q == 2) ? c2 : c3;
#pragma unroll
            for (int s = 0; s < 16; ++s) { const int t = 16 * q + s; hh = As[t * 16 + col] * hh + Us[t * 16 + col];
                const float yv = bf2f(Z[(m0 + t) * INP + ZC_LRY + c]);
                MX[(m0 + t) * 1024 + 256 + c] = f2bf(hh * gelu_tanh(yv)); } }
        LDS_WAIT(); asm volatile("" ::: "memory");
    }
}

constexpr int GO_LG = 0, GO_QIN = 12288, GO_KIN = 21504, GO_KDT = 30720, GO_VT = 37632, GO_SC = 51456, GO_ST = 60672, GO_OB = 74496, GO_GL = 99328, GO_BL = 103424, GO_LS = 103680, GO_WG = 103936;
template <bool FULL> __device__ __forceinline__ void gla_unit(const Args& a, const Ctx& X0, int l, int u) {
    UNIT_CTX(X0);
    const int b = u >> 6, h = (u >> 4) & 3, sc = u & 15;
    const bf16* Z = WSP(bf16, WS_A0); bf16* MX = WSP(bf16, WS_A1);
    float* AGG = MISCP(float, l, MO_GLA);
    LAS float* LG = (LAS float*)(X.lds + GO_LG); LAS bf16* QIN = (LAS bf16*)(X.lds + GO_QIN); LAS bf16* KIN = (LAS bf16*)(X.lds + GO_KIN); LAS bf16* KDT = (LAS bf16*)(X.lds + GO_KDT);
    LAS bf16* VT = (LAS bf16*)(X.lds + GO_VT); LAS bf16* SC = (LAS bf16*)(X.lds + GO_SC); LAS bf16* ST = (LAS bf16*)(X.lds + GO_ST); LAS float* OB = (LAS float*)(X.lds + GO_OB);
    LAS float* GL = (LAS float*)(X.lds + GO_GL); LAS float* BL = (LAS float*)(X.lds + GO_BL); LAS float* LS = (LAS float*)(X.lds + GO_LS); LAS float* WG = (LAS float*)(X.lds + GO_WG);
    const int col = X.lane & 15, q = X.lane >> 4;
    for (int i = X.tid; i < 16 * 48; i += 512) WG[i] = AIN(I_GWG)[(l * 16 + i / 48) * 192 + h * 48 + i % 48];
    if (X.tid < 48) LS[X.tid] = 0.f;
    if (FULL) { for (int i = X.tid; i < 64 * 16; i += 512) { const int r = i >> 4, cc = 48 + (i & 15); QIN[r * 72 + cc] = 0; KIN[r * 72 + cc] = 0; }
                for (int i = X.tid; i < 96 * 16; i += 512) { const int r = i >> 4, cc = 48 + (i & 15); ST[r * 72 + cc] = 0; } }
    f32x4 Sacc[3];
#pragma unroll
    for (int i = 0; i < 3; ++i) Sacc[i] = (f32x4){0.f, 0.f, 0.f, 0.f};
    if (FULL) {
        for (int s2 = 0; s2 < sc; ++s2) { const float* ag = AGG + (size_t)((b * 4 + h) * 16 + s2) * GLA_AGG;
#pragma unroll
            for (int i = 0; i < 3; ++i) { const int ti = X.wave + 8 * i; if (ti < 18) { const int dt = ti / 6, et = ti % 6;
#pragma unroll
                for (int r = 0; r < 4; ++r) { const int d = dt * 16 + 4 * q + r; Sacc[i][r] = __expf(ag[d]) * Sacc[i][r] + ag[48 + d * 96 + et * 16 + col]; } } } }
    }
    BSYNC();
    for (int ch = 0; ch < 4; ++ch) {
        const int t0 = sc * 256 + ch * 64; const size_t m0 = (size_t)b * S_ + t0;
        { const int c = X.tid >> 3, r2 = (X.tid & 7) * 2; const unsigned w = *(const unsigned*)(Z + (m0 + c) * INP + ZC_GLR + r2); GL[c * 16 + r2] = lo_f(w); GL[c * 16 + r2 + 1] = hi_f(w); }
        for (int idx = X.tid; idx < 64 * 48; idx += 512) { const int c = idx / 48, e2 = idx % 48;
            const unsigned w = *(const unsigned*)(Z + (m0 + c) * INP + ZC_V + h * 96 + 2 * e2);
            VT[(2 * e2) * 72 + c] = (bf16)(w & 0xffffu); VT[(2 * e2 + 1) * 72 + c] = (bf16)(w >> 16); }
        BSYNC();
        for (int o = X.tid; o < 64 * 48; o += 512) { const int c = o / 48, d = o % 48; float s = AIN(I_GBG)[l * 192 + h * 48 + d];
#pragma unroll
            for (int r = 0; r < 16; ++r) s += GL[c * 16 + r] * WG[r * 48 + d];
            const float ls = fminf(s, 0.f) - log1pf(__expf(-fabsf(s)));
            LG[c * 48 + d] = ls * 0.0625f; }
        BSYNC();
        if (X.tid < 48) { float s = 0.f; for (int c = 0; c < 64; ++c) { s += LG[c * 48 + X.tid]; LG[c * 48 + X.tid] = s; } BL[X.tid] = s; }
        BSYNC();
        for (int idx = X.tid; idx < 64 * 48; idx += 512) { const int c = idx / 48, d = idx % 48;
            const float kk = bf2f(Z[(m0 + c) * INP + ZC_K + h * 48 + d]); const float bc = LG[c * 48 + d], bl = BL[d];
            KDT[d * 72 + c] = f2bf(kk * __expf(bl - bc));
            if (FULL) { const float qq = bf2f(Z[(m0 + c) * INP + ZC_Q + h * 48 + d]);
                QIN[c * 72 + d] = f2bf(qq * 0.14433756729740643f * __expf(bc)); KIN[c * 72 + d] = f2bf(kk * __expf(-bc)); } }
        if (FULL) {
#pragma unroll
            for (int i = 0; i < 3; ++i) { const int ti = X.wave + 8 * i; if (ti < 18) { const int dt = ti / 6, et = ti % 6;
                v2u o; o.x = pk2(Sacc[i][0], Sacc[i][1]); o.y = pk2(Sacc[i][2], Sacc[i][3]);
                *(LAS v2u*)(ST + (et * 16 + col) * 72 + dt * 16 + 4 * q) = o; } } }
        BSYNC();
        if (FULL) {
            for (int tl = X.wave; tl < 16; tl += 8) { const int ct = tl >> 2, jt = tl & 3;
                f32x4 acc = {0.f, 0.f, 0.f, 0.f};
                if (jt <= ct) {
#pragma unroll
                    for (int ks = 0; ks < 2; ++ks) { const bf16x8 av = *(const LAS bf16x8*)(QIN + (ct * 16 + col) * 72 + ks * 32 + 8 * q), bv = *(const LAS bf16x8*)(KIN + (jt * 16 + col) * 72 + ks * 32 + 8 * q);
                        acc = __builtin_amdgcn_mfma_f32_16x16x32_bf16(av, bv, acc, 0, 0, 0); } }
#pragma unroll
                for (int r = 0; r < 4; ++r) { const int c = ct * 16 + 4 * q + r, j = jt * 16 + col; SC[c * 72 + j] = (j <= c) ? f2bf(acc[r]) : (bf16)0; } }
        }
#pragma unroll
        for (int i = 0; i < 3; ++i) { const int ti = X.wave + 8 * i; if (ti < 18) { const int dt = ti / 6, et = ti % 6;
            f32x4 acc;
#pragma unroll
            for (int r = 0; r < 4; ++r) acc[r] = __expf(BL[dt * 16 + 4 * q + r]) * Sacc[i][r];
#pragma unroll
            for (int ks = 0; ks < 2; ++ks) { const bf16x8 av = *(const LAS bf16x8*)(KDT + (dt * 16 + col) * 72 + ks * 32 + 8 * q), bv = *(const LAS bf16x8*)(VT + (et * 16 + col) * 72 + ks * 32 + 8 * q);
                acc = __builtin_amdgcn_mfma_f32_16x16x32_bf16(av, bv, acc, 0, 0, 0); }
            Sacc[i] = acc; } }
        if (X.tid < 48) LS[X.tid] += BL[X.tid];
        if (FULL) {
            BSYNC();
            for (int tl = X.wave; tl < 24; tl += 8) { const int ct = tl / 6, et = tl % 6;
                f32x4 acc = {0.f, 0.f, 0.f, 0.f};
#pragma unroll
                for (int ks = 0; ks < 2; ++ks) { const bf16x8 av = *(const LAS bf16x8*)(SC + (ct * 16 + col) * 72 + ks * 32 + 8 * q), bv = *(const LAS bf16x8*)(VT + (et * 16 + col) * 72 + ks * 32 + 8 * q);
                    acc = __builtin_amdgcn_mfma_f32_16x16x32_bf16(av, bv, acc, 0, 0, 0); }
#pragma unroll
                for (int ks = 0; ks < 2; ++ks) { const bf16x8 av = *(const LAS bf16x8*)(QIN + (ct * 16 + col) * 72 + ks * 32 + 8 * q), bv = *(const LAS bf16x8*)(ST + (et * 16 + col) * 72 + ks * 32 + 8 * q);
                    acc = __builtin_amdgcn_mfma_f32_16x16x32_bf16(av, bv, acc, 0, 0, 0); }
#pragma unroll
                for (int r = 0; r < 4; ++r) OB[(ct * 16 + 4 * q + r) * 97 + et * 16 + col] = acc[r]; }
            BSYNC();
            for (int i = 0; i < 8; ++i) { const int c = X.wave * 8 + i;
                const float o0 = OB[c * 97 + X.lane], o1 = (X.lane < 32) ? OB[c * 97 + 64 + X.lane] : 0.f;
                const float rstd = 1.0f / sqrtf(wave_sum(o0 * o0 + o1 * o1) * (1.0f / 96.0f) + EPS_);
                const bf16* zr = Z + (m0 + c) * INP + ZC_OG + h * 96; bf16* mr = MX + (m0 + c) * 1024 + 640 + h * 96;
                { const float og = bf2f(zr[X.lane]); mr[X.lane] = f2bf(o0 * rstd * AIN(I_GNG)[l * 384 + h * 96 + X.lane] * og * sigm(og)); }
                if (X.lane < 32) { const float og = bf2f(zr[64 + X.lane]); mr[64 + X.lane] = f2bf(o1 * rstd * AIN(I_GNG)[l * 384 + h * 96 + 64 + X.lane] * og * sigm(og)); } }
        }
        BSYNC();
    }
    if (!FULL) { float* ag = AGG + (size_t)u * GLA_AGG;
        if (X.tid < 48) ag[X.tid] = LS[X.tid];
#pragma unroll
        for (int i = 0; i < 3; ++i) { const int ti = X.wave + 8 * i; if (ti < 18) { const int dt = ti / 6, et = ti % 6;
#pragma unroll
            for (int r = 0; r < 4; ++r) ag[48 + (dt * 16 + 4 * q + r) * 96 + et * 16 + col] = Sacc[i][r]; } } }
    BSYNC();
}
__device__ __forceinline__ void p5a_unit(const Args& a, const Ctx& X0, int l, int u) {
    UNIT_CTX(X0);
    const size_t m0 = (size_t)u * 64; const int b = u >> 6;
    bf16* H = WSP(bf16, WS_A2);
    LAS float* HR = (LAS float*)X.lds;
    LAS float* LOG = (LAS float*)(X.lds + 65536);
    float wr[3][16];
#pragma unroll
    for (int o = 0; o < 3; ++o) { const int j = X.wave + 8 * o;
#pragma unroll
        for (int jj = 0; jj < 4; ++jj)
#pragma unroll
            for (int i = 0; i < 4; ++i) { const int k = 4 * X.lane + 256 * jj + i; float w = 0.f;
                if (j < 4) w = AIN(I_WRG)[(size_t)l * 4096 + k * 4 + j];
                else if (j < 20) w = AIN(I_WRE)[(size_t)l * 16384 + ((j - 4) >> 2) * 4096 + k * 4 + ((j - 4) & 3)];
                wr[o][jj * 4 + i] = w; } }
    const float* md = MODP(a) + (size_t)(l * 4 + b) * 6144;
    for (int sub = 0; sub < 4; ++sub) {
#pragma unroll
        for (int rr = 0; rr < 2; ++rr) { const int row = X.wave * 2 + rr; const size_t m = m0 + sub * 16 + row;
            f32x4 v[4]; float ss = 0.f;
#pragma unroll
            for (int j = 0; j < 4; ++j) { v[j] = ((const f32x4*)(a.out + m * 1024))[X.lane + 64 * j]; ss += (v[j].x * v[j].x + v[j].y * v[j].y) + (v[j].z * v[j].z + v[j].w * v[j].w); }
            const float rstd = 1.0f / sqrtf(wave_sum(ss) * (1.0f / 1024.0f) + EPS_);
#pragma unroll
            for (int j = 0; j < 4; ++j) { const f32x4 g = ((const f32x4*)(AIN(I_GFFN) + l * 1024))[X.lane + 64 * j], sh = ((const f32x4*)(md + 3 * 1024))[X.lane + 64 * j], sc = ((const f32x4*)(md + 4 * 1024))[X.lane + 64 * j];
                const f32x4 h = v[j] * rstd * g * (sc + 1.0f) + sh;
                v2u o; o.x = pk2(h.x, h.y); o.y = pk2(h.z, h.w); ((v2u*)(H + m * 1024))[X.lane + 64 * j] = o;
                *(LAS f32x4*)(HR + row * 1024 + (X.lane + 64 * j) * 4) = h; } }
        BSYNC();
        for (int r = 0; r < 16; ++r) {
            f32x4 hv[4];
#pragma unroll
            for (int j = 0; j < 4; ++j) hv[j] = *(LAS f32x4*)(HR + r * 1024 + (X.lane + 64 * j) * 4);
#pragma unroll
            for (int o = 0; o < 3; ++o) { const int jo = X.wave + 8 * o;
                if (jo < 20) { float s = 0.f;
#pragma unroll
                    for (int j = 0; j < 4; ++j) s += (hv[j].x * wr[o][j * 4] + hv[j].y * wr[o][j * 4 + 1]) + (hv[j].z * wr[o][j * 4 + 2] + hv[j].w * wr[o][j * 4 + 3]);
                    s = wave_sum(s);
                    if (X.lane == 0) LOG[(sub * 16 + r) * 20 + jo] = s + ((jo < 4) ? AIN(I_BRG)[l * 4 + jo] : AIN(I_BRE)[l * 16 + (jo - 4)]); } }
        }
        BSYNC();
    }
    if (X.wave == 0) {
        const int row = X.lane; const LAS float* lg = LOG + row * 20;
        int gs = 0; float gm = lg[0];
#pragma unroll
        for (int i = 1; i < 4; ++i) if (lg[i] > gm) { gm = lg[i]; gs = i; }
        float den = 0.f;
#pragma unroll
        for (int i = 0; i < 4; ++i) den += __expf(lg[i] - gm);
        const float psel = 1.0f / den;
        const float e0 = lg[4 + gs * 4], e1 = lg[5 + gs * 4], e2 = lg[6 + gs * 4], e3 = lg[7 + gs * 4];
        int i0 = 0; float v0 = e0;
        if (e1 > v0) { v0 = e1; i0 = 1; } if (e2 > v0) { v0 = e2; i0 = 2; } if (e3 > v0) { v0 = e3; i0 = 3; }
        int i1 = -1; float v1 = 0.f;
        if (i0 != 0) { v1 = e0; i1 = 0; }
        if (i0 != 1 && (i1 < 0 || e1 > v1)) { v1 = e1; i1 = 1; }
        if (i0 != 2 && (i1 < 0 || e2 > v1)) { v1 = e2; i1 = 2; }
        if (i0 != 3 && (i1 < 0 || e3 > v1)) { v1 = e3; i1 = 3; }
        const float tt = __expf(v1 - v0), w0 = psel / (1.0f + tt), w1 = psel * tt / (1.0f + tt);
        const int E0 = gs * 4 + i0, E1 = gs * 4 + i1;
        const unsigned long long below = (1ull << row) - 1ull;
        int rank0 = 0, rank1 = 0, mycnt = 0;
        for (int e = 0; e < 16; ++e) { const unsigned long long b0 = __ballot(E0 == e), b1 = __ballot(E1 == e);
            const int rk = __popcll(b0 & below) + __popcll(b1 & below);
            if (E0 == e) rank0 = rk; if (E1 == e) rank1 = rk;
            if (row == e) mycnt = __popcll(b0) + __popcll(b1); }
        const size_t m = m0 + row;
        MISCP(int, l, MO_TOKE)[2 * m] = E0; MISCP(int, l, MO_TOKE)[2 * m + 1] = E1;
        MISCP(float, l, MO_TOKW)[2 * m] = w0; MISCP(float, l, MO_TOKW)[2 * m + 1] = w1;
        MISCP(int, l, MO_TOKR)[2 * m] = rank0; MISCP(int, l, MO_TOKR)[2 * m + 1] = rank1;
        if (row < 16) MISCP(int, l, MO_BCNT)[u * 16 + row] = mycnt;
    }
    BSYNC();
}
__device__ __forceinline__ void p5b_phase(const Args& a, const Ctx& X, int l) {
    const int zo = 0;
    const int* BC = MISCP(int, l, MO_BCNT);
    LAS int* PART = (LAS int*)X.lds;
    LAS int* TOT = PART + 512; LAS int* OFF = TOT + 16; LAS int* PRE = OFF + 16; LAS int* POSL = PRE + 32;
    { const int e = X.tid & 15, part = X.tid >> 4; int s = 0;
#pragma unroll
      for (int i = 0; i < 8; ++i) s += __hip_atomic_load(BC + (part * 8 + i) * 16 + e, RLX_AGENT);
      PART[part * 16 + e] = s; }
    BSYNC();
    if (X.tid < 16) { int s = 0; for (int p = 0; p < 32; ++p) s += PART[p * 16 + X.tid]; TOT[X.tid] = s; }
    BSYNC();
    if (X.tid == 0) { int p = 0; for (int e = 0; e < 16; ++e) { PRE[e] = p; p += (TOT[e] + 255) >> 8; } PRE[16] = p;
        if (blockIdx.x == 0) { int* gp = MISCP(int, l, MO_PRE); for (int e = 0; e < 17; ++e) gp[e] = PRE[e]; } }
    BSYNC();
    const bf16* H = WSP(bf16, WS_A2); bf16* HS = WSP(bf16, WS_A0);
    for (int u = X.vcu; u < 256; u += X.G) {
        if (X.tid < 16) { int s = 0; const int pu = u >> 3; for (int p = 0; p < pu; ++p) s += PART[p * 16 + X.tid];
            for (int uu = pu * 8; uu < u; ++uu) s += __hip_atomic_load(BC + uu * 16 + X.tid, RLX_AGENT);
            OFF[X.tid] = s; }
        BSYNC();
        if (X.tid < 128) { const size_t m = (size_t)u * 64 + (X.tid >> 1); const int k = X.tid & 1;
            const int E = MISCP(int, l, MO_TOKE)[2 * m + k];
            const int pos = PRE[E] * 256 + OFF[E] + MISCP(int, l, MO_TOKR)[2 * m + k];
            MISCP(int, l, MO_TOKP)[2 * m + k] = pos; MISCP(float, l, MO_ROWW)[pos] = MISCP(float, l, MO_TOKW)[2 * m + k]; POSL[X.tid] = pos; }
        BSYNC();
        for (int i = 0; i < 16; ++i) { const int ent = X.wave * 16 + i; const size_t m = (size_t)u * 64 + (ent >> 1);
            const v4u* src = (const v4u*)(H + m * 1024); v4u* dst = (v4u*)(HS + (size_t)POSL[ent] * 1024);
            const v4u x0 = src[X.lane], x1 = src[X.lane + 64]; dst[X.lane] = x0; dst[X.lane + 64] = x1; }
        BSYNC();
    }
    for (int e = X.vcu; e < 16; e += X.G) { const int r0 = PRE[e] * 256 + TOT[e], r1 = PRE[e + 1] * 256; for (int r = r0 + X.tid; r < r1; r += 512) MISCP(float, l, MO_ROWW)[r] = 0.f; }
}

__device__ __forceinline__ float dot_bf16(const bf16* x, const bf16* w, int K) {
    float s = 0.f;
    for (int k = 0; k < K; k += 8) { const v4u xv = *(const v4u*)(x + k), wv = *(const v4u*)(w + k);
        s += lo_f(xv.x) * lo_f(wv.x) + hi_f(xv.x) * hi_f(wv.x) + lo_f(xv.y) * lo_f(wv.y) + hi_f(xv.y) * hi_f(wv.y) + lo_f(xv.z) * lo_f(wv.z) + hi_f(xv.z) * hi_f(wv.z) + lo_f(xv.w) * lo_f(wv.w) + hi_f(xv.w) * hi_f(wv.w); }
    return s;
}
template <int KIND> __device__ __forceinline__ void naive_gemm(const Args& a, const Ctx& X, int l) {
    const int zo = 0;
    const size_t gt = (size_t)X.vcu * 512 + X.tid, NT = (size_t)X.G * 512;
    if (KIND == 0) { const bf16* A = WSP(bf16, WS_A2); const bf16* Bt = WSP(bf16, WS_WIN) + (size_t)l * INP * 1024; bf16* Zo = WSP(bf16, WS_A0);
        for (size_t i = gt; i < (size_t)T_ * INP; i += NT) { const size_t r = i / INP, c = i % INP; Zo[i] = f2bf(dot_bf16(A + r * 1024, Bt + c * 1024, 1024)); } }
    if (KIND == 1) { const bf16* A = WSP(bf16, WS_A1); const bf16* Bt = WSP(bf16, WS_WOUT) + (size_t)l * 1048576; const float* xin = (l == 0) ? a.in[I_X] : a.out;
        for (size_t i = gt; i < (size_t)T_ * 1024; i += NT) { const size_t r = i >> 10, c = i & 1023; const float g = MODP(a)[((size_t)(l * 4 + (r >> 12)) * 6 + 2) * 1024 + c];
            a.out[i] = xin[i] + g * dot_bf16(A + r * 1024, Bt + c * 1024, 1024); } }
    if (KIND == 2 || KIND == 3) {
        const int* gp = MISCP(int, l, MO_PRE); const int nrows = gp[16] * 256;
        if (KIND == 2) { const bf16* A = WSP(bf16, WS_A0); const bf16* Bt = WSP(bf16, WS_WGU) + (size_t)l * 16 * 1048576; bf16* Ho = WSP(bf16, WS_A1); const float* rw = MISCP(float, l, MO_ROWW);
            for (size_t i = gt; i < (size_t)nrows * 512; i += NT) { const size_t r = i >> 9, f = i & 511; const int mt = (int)(r >> 8); int e = 0; for (int k = 1; k < 16; ++k) e += (mt >= gp[k]) ? 1 : 0;
                const bf16* W = Bt + (size_t)e * 1048576 + ((f >> 7) * 256 + (f & 127)) * 1024;
                const float g = dot_bf16(A + r * 1024, W, 1024), up = dot_bf16(A + r * 1024, W + 128 * 1024, 1024);
                Ho[i] = f2bf(g * sigm(g) * up * rw[r]); } }
        else { const bf16* A = WSP(bf16, WS_A1); const bf16* Bt = WSP(bf16, WS_WD) + (size_t)l * 16 * 524288; bf16* Yo = WSP(bf16, WS_A0);
            for (size_t i = gt; i < (size_t)nrows * 1024; i += NT) { const size_t r = i >> 10, c = i & 1023; const int mt = (int)(r >> 8); int e = 0; for (int k = 1; k < 16; ++k) e += (mt >= gp[k]) ? 1 : 0;
                Yo[i] = f2bf(dot_bf16(A + r * 512, Bt + (size_t)e * 524288 + c * 512, 512)); } }
    }
}
constexpr int N_PHASES = 20;
#if MK_PER_PHASE
#define SEAM(k) do { } while (0)
#else
#define SEAM(k) do { if ((k) + 1 < hi) xcd_barrier(bar); } while (0)
#endif
#ifndef PH_MASK
#define PH_MASK 0xFFFFF
#endif
#define IN(k) (((PH_MASK >> (k)) & 1) && lo <= (k) && (k) < hi)
template <int L> __device__ __forceinline__ void layer_program(const Args& a, LAS unsigned char* lds, const XcdBarrier& bar, const int lo, const int hi) {
    constexpr int l = L, base = 1 + 9 * L; const int zo = 0;
    if (IN(base + 0)) { const Ctx X = mkctx(lds); if (L == 0) row_phase<0>(a, X, 0); else row_phase<1>(a, X, l); SEAM(base + 0); }
    if (IN(base + 1)) { const Ctx X = mkctx(lds);
#if NAIVE_GEMM_MASK & 1
        naive_gemm<0>(a, X, l);
#else
        pg8::Gemm g{WSP(bf16, WS_A2), WSP(bf16, WS_WIN) + (size_t)l * INP * 1024, T_, INP, 1024}; pg8::StaticOrder S; S.init(T_, INP, X.G, X.bx);
        pg8::EpiBf16<0> E{WSP(bf16, WS_A0), INP, nullptr, 0, 0, 1.f};
        pg8::gemm_phase<pg8::EpiBf16<0>, pg8::StaticOrder, true, true>(X.lds, g, S, E);
#endif
        SEAM(base + 1); }
    if (IN(base + 2)) { const Ctx X = mkctx(lds); for (int u = X.vcu; u < 256; u += X.G) { conv_unit(a, X, l, u); BSYNC(); lru_unit<false>(a, X, l, u); BSYNC(); gla_unit<false>(a, X, l, u); } SEAM(base + 2); }
    if (IN(base + 3)) { const Ctx X = mkctx(lds); for (int u = X.vcu; u < 256; u += X.G) { lru_unit<true>(a, X, l, u); BSYNC(); gla_unit<true>(a, X, l, u); } SEAM(base + 3); }
    if (IN(base + 4)) { const Ctx X = mkctx(lds);
#if NAIVE_GEMM_MASK & 2
        naive_gemm<1>(a, X, l);
#else
        pg8::Gemm g{WSP(bf16, WS_A1), WSP(bf16, WS_WOUT) + (size_t)l * 1048576, T_, 1024, 1024}; pg8::StaticOrder S; S.init(T_, 1024, X.G, X.bx);
        pg8::EpiResid E{(l == 0) ? a.in[I_X] : a.out, a.out, MODP(a) + ((size_t)(l * 4) * 6 + 2) * 1024};
        pg8::gemm_phase<pg8::EpiResid, pg8::StaticOrder, true, true>(X.lds, g, S, E);
#endif
        SEAM(base + 4); }
    if (IN(base + 5)) { const Ctx X = mkctx(lds); for (int u = X.vcu; u < 256; u += X.G) p5a_unit(a, X, l, u); SEAM(base + 5); }
    if (IN(base + 6)) { const Ctx X = mkctx(lds); p5b_phase(a, X, l); SEAM(base + 6); }
    if (IN(base + 7)) { const Ctx X = mkctx(lds);
#if NAIVE_GEMM_MASK & 4
        naive_gemm<2>(a, X, l);
#else
        const int* gp = MISCP(int, l, MO_PRE);
        pg8::GroupedOrder S;
#pragma unroll
        for (int e = 0; e < 17; ++e) S.pre[e] = __builtin_amdgcn_readfirstlane(__hip_atomic_load(gp + e, RLX_AGENT));
        S.nwg = S.pre[16] * 4; S.G = X.G; S.c = X.bx;
        pg8::Gemm g{WSP(bf16, WS_A0), WSP(bf16, WS_WGU) + (size_t)l * 16 * 1048576, NROWS_PAD, 16384, 1024};
        pg8::EpiHid E{WSP(bf16, WS_A1), MISCP(float, l, MO_ROWW)};
        pg8::gemm_phase<pg8::EpiHid, pg8::GroupedOrder, true, true>(X.lds, g, S, E);
#endif
        SEAM(base + 7); }
    if (IN(base + 8)) { const Ctx X = mkctx(lds);
#if NAIVE_GEMM_MASK & 8
        naive_gemm<3>(a, X, l);
#else
        const int* gp = MISCP(int, l, MO_PRE);
        pg8::GroupedOrder S;
#pragma unroll
        for (int e = 0; e < 17; ++e) S.pre[e] = __builtin_amdgcn_readfirstlane(__hip_atomic_load(gp + e, RLX_AGENT));
        S.nwg = S.pre[16] * 4; S.G = X.G; S.c = X.bx;
        pg8::Gemm g{WSP(bf16, WS_A1), WSP(bf16, WS_WD) + (size_t)l * 16 * 524288, NROWS_PAD, 16384, 512};
        pg8::EpiY E{WSP(bf16, WS_A0)};
        pg8::gemm_phase<pg8::EpiY, pg8::GroupedOrder, true, true>(X.lds, g, S, E);
#endif
        SEAM(base + 8); }
}
__global__ void __launch_bounds__(NWAVES * 64, 2) mk_fwd(Args a) {
    extern __shared__ __attribute__((aligned(16))) unsigned char lds_raw[];
    LAS unsigned char* lds = (LAS unsigned char*)lds_raw;
    volatile LAS unsigned* MISC = (volatile LAS unsigned*)(lds + MISC_OFF);
    for (int u = threadIdx.x; u < (LDS_BYTES - LDSCTL_OFF) / 4; u += NWAVES * 64) ((LAS unsigned*)(lds + LDSCTL_OFF))[u] = 0u;
    __syncthreads();
    gu32* ctl = (gu32*)(a.ws + WS_CTL);
    XcdBarrier bar; bar.bar = (unsigned*)(ctl + CW_BAR); bar.x = 0; bar.st = nullptr;
#if !MK_PER_PHASE
    bar = xcd_barrier_post((unsigned*)(ctl + CW_BAR), MISC + 8);
#endif
    const int lo = a.ph_lo, hi = a.ph_hi;
    if (IN(0)) { const Ctx X = mkctx(lds); p0_prologue(a, X); SEAM(0); }
    layer_program<0>(a, lds, bar, lo, hi);
    layer_program<1>(a, lds, bar, lo, hi);
    if (IN(N_PHASES - 1)) { const Ctx X = mkctx(lds); row_phase<2>(a, X, 2); }
}
#undef IN

extern "C" void kernel_launch(void* const* d_in, const int* in_sizes, int n_in, void* d_out, int out_size, void* d_ws, size_t ws_size, hipStream_t stream) {
    static int grid = 0;
    if (grid == 0) {
        if (n_in != 30 || in_sizes[0] != T_ * D_ || out_size != T_ * D_ || ws_size < WS_END) { fprintf(stderr, "kernel_launch: unexpected shapes (n_in %d, in0 %d, out %d, ws %zu); nothing launched\n", n_in, n_in > 0 ? in_sizes[0] : -1, out_size, ws_size); grid = -1; return; }
        int dev = 0, cus = 0, per_cu = 0;
        if (hipGetDevice(&dev) != hipSuccess || hipDeviceGetAttribute(&cus, hipDeviceAttributeMultiprocessorCount, dev) != hipSuccess) { fprintf(stderr, "kernel_launch: device query failed\n"); grid = -1; return; }
        if (hipFuncSetAttribute((const void*)mk_fwd, hipFuncAttributeMaxDynamicSharedMemorySize, LDS_BYTES) != hipSuccess) { fprintf(stderr, "kernel_launch: hipFuncSetAttribute failed\n"); grid = -1; return; }
        if (hipOccupancyMaxActiveBlocksPerMultiprocessor(&per_cu, (const void*)mk_fwd, NWAVES * 64, LDS_BYTES) != hipSuccess || per_cu < 1) { fprintf(stderr, "kernel_launch: occupancy query says %d blocks per CU\n", per_cu); per_cu = 1; }
        (void)hipGetLastError();
        grid = cus;
        if (grid > 256) grid = 256;
    }
    if (grid < 0) return;
    (void)hipMemsetAsync((char*)d_ws + WS_CTL, 0, CTL_ZERO_BYTES, stream);
    Args a{};
    for (int i = 0; i < 30; ++i) a.in[i] = (const float*)d_in[i];
    a.out = (float*)d_out; a.ws = (unsigned char*)d_ws;
#if MK_PER_PHASE
    for (int ph = 0; ph < N_PHASES; ++ph) { a.ph_lo = ph; a.ph_hi = ph + 1; a.li = ph; hipLaunchKernelGGL(mk_fwd, dim3(grid), dim3(NWAVES * 64), LDS_BYTES, stream, a); }
#else
    a.ph_lo = 0; a.ph_hi = N_PHASES; a.li = 0;
    hipLaunchKernelGGL(mk_fwd, dim3(grid), dim3(NWAVES * 64), LDS_BYTES, stream, a);
#endif
}
```

```cpp
#include <hip/hip_runtime.h>
#include <cstdio>
#include <cstdint>
namespace pg8 {
#define PG8_LAS __attribute__((address_space(3)))
typedef unsigned short bf16_t;
typedef short bf16x8 __attribute__((ext_vector_type(8)));
typedef float f32x4 __attribute__((ext_vector_type(4)));
typedef unsigned u32x4 __attribute__((ext_vector_type(4)));
constexpr int BM = 256, BK = 64, HALF = 128, HTB = HALF * BK * 2  , STAGE_BYTES = 8 * HTB, NXCD = 8, WGM = 8;

__host__ __device__ __forceinline__ int lds_byte(int r, int c) { const int st = (r >> 4) * 2 + (c >> 5), rr = r & 15, cc = c & 31, ob = rr * 64 + cc * 2; return st * 1024 + (ob ^ (((ob >> 9) & 1) << 5)); }
__host__ __device__ __forceinline__ void stage_rc(int b, int& R, int& C) { const int st = b / 1024, sb = b % 1024, swz = sb ^ (((sb >> 9) & 1) << 5); R = (st >> 1) * 16 + swz / 64; C = (st & 1) * 32 + (swz % 64) / 2; }
__host__ __device__ __forceinline__ int perm32(int rho) { const int n = rho >> 4, i = rho & 15; return 8 * (i >> 2) + 4 * n + (i & 3); }

struct Unit { int pm, pn; };
struct Gemm { const bf16_t* A; const bf16_t* Bt; int M, N, K; };

struct StaticOrder {
    int nM, nN, nwg, G, c;
    __host__ __device__ void init(int M, int N, int G_, int c_) { nM = M / BM; nN = N / BM; nwg = nM * nN; G = G_; c = c_; }
    __host__ __device__ bool next(int i, Unit& u) const {
        const long L = (long)i * G + c; if (L >= nwg) return false;
        int wgid = (int)L; { const int q = nwg / NXCD, r = nwg % NXCD, xcd = wgid % NXCD, off = wgid / NXCD; wgid = (xcd < r ? xcd * (q + 1) : r * (q + 1) + (xcd - r) * q) + off; }
        const int nig = WGM * nN, gid = wgid / nig, fm = gid * WGM, gsz = (nM - fm) < WGM ? (nM - fm) : WGM;
        u.pm = fm + ((wgid % nig) % gsz); u.pn = (wgid % nig) / gsz; return true;
    }
    __device__ __forceinline__ void a_ready(const Unit&) const {}
    __device__ __forceinline__ void done(const Unit&) const {}
};
typedef float f32x2c_t __attribute__((ext_vector_type(2))); typedef __bf16 bf16x2c_t __attribute__((ext_vector_type(2)));
__device__ __forceinline__ unsigned cvt_pk_bf16(float lo, float hi) { const f32x2c_t v = {lo, hi}; const bf16x2c_t b = __builtin_convertvector(v, bf16x2c_t); return __builtin_bit_cast(unsigned, b); }
typedef float f32x2 __attribute__((ext_vector_type(2)));
__device__ __forceinline__ f32x2 gelu_pk(f32x2 v) {
    const f32x2 av = __builtin_elementwise_abs(v), d = av * 0.2316418882f + 1.0f;
    f32x2 t; t.x = __builtin_amdgcn_rcpf(d.x); t.y = __builtin_amdgcn_rcpf(d.y);
    f32x2 q = t * 0.5307027145f + (-0.7265760135f); q = q * t + 0.7107068705f; q = q * t + (-0.142248368f); q = q * t + 0.127414796f; q = q * t;
    const f32x2 s = (v * v) * (-0.72134752044f);
    f32x2 e; e.x = __builtin_amdgcn_exp2f(s.x); e.y = __builtin_amdgcn_exp2f(s.y);
    const f32x2 m = v * (q * e), r = v - m;
    f32x2 o; o.x = v.x < 0.f ? m.x : r.x; o.y = v.y < 0.f ? m.y : r.y; return o;
}
template <int ACT  > struct EpiBf16 {
    static constexpr bool PERM = true, AFTER_DRAIN = false; static_assert(ACT == 0 || ACT == 1, "EpiBf16: ACT is 0 (none) or 1 (gelu_pk)");
    bf16_t* O; int ldc; const float* bias; int split_cols; size_t split_stride; float scale0;
    __device__ __forceinline__ void operator()(const f32x4 (&acc)[2][2][4][2], const Unit& u, int wr, int wc, int fr, int fq) const {
        const int row0 = u.pm * BM + wr * 64 + fr; int colt = u.pn * BM; bf16_t* base = O;
        float sc = 1.f; if (split_cols) { const int t = colt / split_cols; base += (size_t)t * split_stride; colt -= t * split_cols; if (t == 0) sc = scale0; }
        const int col0 = colt + wc * 32 + 8 * fq, bcol0 = u.pn * BM + wc * 32 + 8 * fq;
        f32x4 bv[2][2];
#pragma unroll
        for (int bj = 0; bj < 2; ++bj)
#pragma unroll
            for (int n = 0; n < 2; ++n) bv[bj][n] = bias ? *(const f32x4*)(bias + bcol0 + bj * HALF + 4 * n) : (f32x4){0.f, 0.f, 0.f, 0.f};
#pragma unroll
        for (int ai = 0; ai < 2; ++ai)
#pragma unroll
            for (int m = 0; m < 4; ++m) { bf16_t* rowp = base + (size_t)(row0 + ai * HALF + m * 16) * ldc + col0;
#pragma unroll
                for (int bj = 0; bj < 2; ++bj) { f32x4 v0 = acc[ai][bj][m][0] + bv[bj][0], v1 = acc[ai][bj][m][1] + bv[bj][1];
                    if (ACT == 1) { f32x2 a = gelu_pk((f32x2){v0[0], v0[1]}), b = gelu_pk((f32x2){v0[2], v0[3]}), c = gelu_pk((f32x2){v1[0], v1[1]}), d = gelu_pk((f32x2){v1[2], v1[3]});
                        v0 = (f32x4){a.x, a.y, b.x, b.y}; v1 = (f32x4){c.x, c.y, d.x, d.y}; }
                    v0 = v0 * sc; v1 = v1 * sc; u32x4 w; w.x = cvt_pk_bf16(v0[0], v0[1]); w.y = cvt_pk_bf16(v0[2], v0[3]); w.z = cvt_pk_bf16(v1[0], v1[1]); w.w = cvt_pk_bf16(v1[2], v1[3]);
                    *(u32x4*)(rowp + bj * HALF) = w; } }
    }
};
struct GroupedOrder {
    int pre[17]; int nwg, G, c;
    __device__ __forceinline__ bool next(int i, Unit& u) const {
        const long L = (long)i * G + c; if (L >= nwg) return false;
        int wgid = (int)L; { const int q = nwg / NXCD, r = nwg % NXCD, xcd = wgid % NXCD, off = wgid / NXCD; wgid = (xcd < r ? xcd * (q + 1) : r * (q + 1) + (xcd - r) * q) + off; }
        const int mt = wgid >> 2, nt = wgid & 3; int e = 0;
#pragma unroll
        for (int k = 1; k < 16; ++k) e += (mt >= pre[k]) ? 1 : 0;
        u.pm = mt; u.pn = e * 4 + nt; return true;
    }
    __device__ __forceinline__ void a_ready(const Unit&) const {}
    __device__ __forceinline__ void done(const Unit&) const {}
};
__device__ __forceinline__ float silu_f(float v) { return v * __builtin_amdgcn_rcpf(1.0f + __expf(-v)); }
struct EpiHid {
    static constexpr bool PERM = true, AFTER_DRAIN = false;
    bf16_t* H; const float* roww;
    __device__ __forceinline__ void operator()(const f32x4 (&acc)[2][2][4][2], const Unit& u, int wr, int wc, int fr, int fq) const {
        const int row0 = u.pm * BM + wr * 64 + fr, f0 = (u.pn & 3) * 128 + wc * 32 + 8 * fq;
#pragma unroll
        for (int ai = 0; ai < 2; ++ai)
#pragma unroll
            for (int m = 0; m < 4; ++m) { const int row = row0 + ai * HALF + m * 16; const float w = roww[row];
                const f32x4 g0 = acc[ai][0][m][0], g1 = acc[ai][0][m][1], u0 = acc[ai][1][m][0], u1 = acc[ai][1][m][1];
                u32x4 o; o.x = cvt_pk_bf16(silu_f(g0[0]) * u0[0] * w, silu_f(g0[1]) * u0[1] * w); o.y = cvt_pk_bf16(silu_f(g0[2]) * u0[2] * w, silu_f(g0[3]) * u0[3] * w);
                o.z = cvt_pk_bf16(silu_f(g1[0]) * u1[0] * w, silu_f(g1[1]) * u1[1] * w); o.w = cvt_pk_bf16(silu_f(g1[2]) * u1[2] * w, silu_f(g1[3]) * u1[3] * w);
                *(u32x4*)(H + (size_t)row * 512 + f0) = o; }
    }
};
struct EpiY {
    static constexpr bool PERM = true, AFTER_DRAIN = false;
    bf16_t* Y;
    __device__ __forceinline__ void operator()(const f32x4 (&acc)[2][2][4][2], const Unit& u, int wr, int wc, int fr, int fq) const {
        const int row0 = u.pm * BM + wr * 64 + fr, col0 = (u.pn & 3) * BM + wc * 32 + 8 * fq;
#pragma unroll
        for (int ai = 0; ai < 2; ++ai)
#pragma unroll
            for (int m = 0; m < 4; ++m) { bf16_t* rowp = Y + (size_t)(row0 + ai * HALF + m * 16) * 1024 + col0;
#pragma unroll
                for (int bj = 0; bj < 2; ++bj) { const f32x4 v0 = acc[ai][bj][m][0], v1 = acc[ai][bj][m][1];
                    u32x4 w; w.x = cvt_pk_bf16(v0[0], v0[1]); w.y = cvt_pk_bf16(v0[2], v0[3]); w.z = cvt_pk_bf16(v1[0], v1[1]); w.w = cvt_pk_bf16(v1[2], v1[3]);
                    *(u32x4*)(rowp + bj * HALF) = w; } }
    }
};
struct EpiResid {
    static constexpr bool PERM = false, AFTER_DRAIN = false;
    const float* xin; float* xout; const float* gate;
    __device__ __forceinline__ void operator()(const f32x4 (&acc)[2][2][4][2], const Unit& u, int wr, int wc, int fr, int fq) const {
        const int row0 = u.pm * BM + wr * 64 + fr, col0 = u.pn * BM + wc * 32 + 4 * fq; const int b = u.pm >> 4;
        f32x4 gv[2][2];
#pragma unroll
        for (int bj = 0; bj < 2; ++bj)
#pragma unroll
            for (int n = 0; n < 2; ++n) gv[bj][n] = *(const f32x4*)(gate + (size_t)b * 6144 + col0 + bj * HALF + n * 16);
#pragma unroll
        for (int ai = 0; ai < 2; ++ai)
#pragma unroll
            for (int m = 0; m < 4; ++m) { const size_t off = (size_t)(row0 + ai * HALF + m * 16) * 1024 + col0;
#pragma unroll
                for (int bj = 0; bj < 2; ++bj)
#pragma unroll
                    for (int n = 0; n < 2; ++n) { const f32x4 xi = *(const f32x4*)(xin + off + bj * HALF + n * 16); *(f32x4*)(xout + off + bj * HALF + n * 16) = xi + gv[bj][n] * acc[ai][bj][m][n]; }
                if (m & 1) asm volatile("" ::: "memory"); }
    }
};
template <class Epi, class Sched, bool ALIGN_EPI = false, bool SP2 = false>
__device__ __forceinline__ void gemm_phase(PG8_LAS unsigned char* lds, const Gemm g, const Sched& S, const Epi& E) {
    const int tid = threadIdx.x, wid = __builtin_amdgcn_readfirstlane(tid >> 6), lane = tid & 63, wr = wid >> 2, wc = wid & 3, fr = lane & 15, fq = lane >> 4;
    const int K = g.K, nt = K / BK;
    unsigned voffA[2], voffB[2];
#pragma unroll
    for (int i = 0; i < 2; ++i) { int R, C; stage_rc(tid * 16 + i * 8192, R, C); const int Rb = Epi::PERM ? ((R & ~31) + perm32(R & 31)) : R;
        voffA[i] = (unsigned)(R * K + C) * 2u; voffB[i] = (unsigned)(Rb * K + C) * 2u; }
    const size_t kstep = (size_t)(BK * 2);
    const size_t hstep = (size_t)HALF * K * 2;
    const size_t tstep = 2 * hstep;
    const unsigned ldsw = (unsigned)wid * 1024u;
    const int aoff = lds_byte(wr * 64 + fr, fq * 8), boff = lds_byte(wc * 32 + fr, fq * 8);
#define PG8_SA(b, h) (((b) * 2 + (h)) * HTB)
#define PG8_SB(b, h) ((4 + (b) * 2 + (h)) * HTB)
#define PG8_STAGE(bufoff, gbase, voff) do { _Pragma("unroll") for (int _i = 0; _i < 2; ++_i) \
        __builtin_amdgcn_global_load_lds((const unsigned*)((const char*)(gbase) + (voff)[_i]), (PG8_LAS unsigned*)(lds + (bufoff) + ldsw + _i * 8192), 16, 0, 0); } while (0)
#define PG8_LDA(dst, b, h) do { _Pragma("unroll") for (int m = 0; m < 4; ++m) _Pragma("unroll") for (int k = 0; k < 2; ++k) dst[m][k] = *(const PG8_LAS bf16x8*)(lds + PG8_SA(b, h) + aoff + m * 2048 + k * 1024); } while (0)
#define PG8_LDB(dst, b, h) do { _Pragma("unroll") for (int n = 0; n < 2; ++n) _Pragma("unroll") for (int k = 0; k < 2; ++k) dst[n][k] = *(const PG8_LAS bf16x8*)(lds + PG8_SB(b, h) + boff + n * 2048 + k * 1024); } while (0)
#define PG8_MMA(ai, bj, At, Bt) do { __builtin_amdgcn_s_setprio(1); _Pragma("unroll") for (int m = 0; m < 4; ++m) _Pragma("unroll") for (int n = 0; n < 2; ++n) _Pragma("unroll") for (int k = 0; k < 2; ++k) \
        acc[ai][bj][m][n] = __builtin_amdgcn_mfma_f32_16x16x32_bf16(Bt[n][k], At[m][k], acc[ai][bj][m][n], 0, 0, 0); __builtin_amdgcn_s_setprio(0); } while (0)
#define PG8_WAIT_V(n) asm volatile("s_waitcnt vmcnt(" #n ")" ::: "memory")
#define PG8_WAIT_L(n) asm volatile("s_waitcnt lgkmcnt(" #n ")" ::: "memory")
#define PG8_BAR __builtin_amdgcn_s_barrier()
#define PG8_SCHED __builtin_amdgcn_sched_barrier(0)
    Unit cur, nxt; int ui = 0;
    if (!S.next(0, cur)) return;
    f32x4 acc[2][2][4][2];
#pragma unroll
    for (int a = 0; a < 2; ++a)
#pragma unroll
        for (int b = 0; b < 2; ++b)
#pragma unroll
            for (int m = 0; m < 4; ++m)
#pragma unroll
                for (int n = 0; n < 2; ++n) acc[a][b][m][n] = (f32x4){0.f, 0.f, 0.f, 0.f};
    bf16x8 At[4][2], B0[2][2], B1[2][2];
    const char* cA = (const char*)g.A + (size_t)cur.pm * tstep; const char* cB = (const char*)g.Bt + (size_t)cur.pn * tstep;
    S.a_ready(cur);
    if constexpr (SP2) {
        PG8_STAGE(PG8_SB(0, 0), cB, voffB); PG8_STAGE(PG8_SB(0, 1), cB + hstep, voffB); PG8_STAGE(PG8_SA(0, 0), cA, voffA); PG8_STAGE(PG8_SA(0, 1), cA + hstep, voffA);
        if (wr == 1) PG8_BAR;
        PG8_WAIT_V(2); PG8_BAR;
        PG8_STAGE(PG8_SB(1, 0), cB + kstep, voffB); PG8_STAGE(PG8_SA(1, 0), cA + kstep, voffA); PG8_STAGE(PG8_SB(1, 1), cB + hstep + kstep, voffB);
        PG8_WAIT_V(6); PG8_BAR;
    } else {
        PG8_STAGE(PG8_SB(0, 0), cB, voffB); PG8_STAGE(PG8_SA(0, 0), cA, voffA); PG8_STAGE(PG8_SB(0, 1), cB + hstep, voffB); PG8_STAGE(PG8_SA(0, 1), cA + hstep, voffA);
        if (wr == 1) PG8_BAR;
        PG8_WAIT_V(4); PG8_BAR;
        PG8_STAGE(PG8_SB(1, 0), cB + kstep, voffB); PG8_STAGE(PG8_SA(1, 0), cA + kstep, voffA); PG8_STAGE(PG8_SB(1, 1), cB + hstep + kstep, voffB);
        PG8_WAIT_V(6); PG8_BAR;
    }
    for (;;) {
        const bool has_next = S.next(ui + 1, nxt);
        const char* nA = has_next ? (const char*)g.A + (size_t)nxt.pm * tstep : cA; const char* nB = has_next ? (const char*)g.Bt + (size_t)nxt.pn * tstep : cB;
        for (int t = 0; t < nt; t += 2) {
            const bool last = (t == nt - 2);
            const char* a1 = cA + (size_t)(t + 1) * kstep;
            const char* a2 = last ? nA : cA + (size_t)(t + 2) * kstep; const char* b2 = last ? nB : cB + (size_t)(t + 2) * kstep;
            const char* a3 = a2 + kstep; const char* b3 = b2 + kstep;
            if (last && has_next) S.a_ready(nxt);
            if constexpr (SP2) {
            PG8_LDB(B0, 0, 0); PG8_LDB(B1, 0, 1); PG8_SCHED; PG8_LDA(At, 0, 0); PG8_STAGE(PG8_SA(1, 1), a1 + hstep, voffA);
            PG8_WAIT_V(8); PG8_WAIT_L(0); PG8_BAR; PG8_MMA(0, 0, At, B0); PG8_MMA(0, 1, At, B1); PG8_BAR; PG8_SCHED;
            PG8_LDA(At, 0, 1); PG8_STAGE(PG8_SB(0, 0), b2, voffB); PG8_STAGE(PG8_SB(0, 1), b2 + hstep, voffB); PG8_STAGE(PG8_SA(0, 0), a2, voffA);
            PG8_WAIT_V(8); PG8_WAIT_L(0); PG8_BAR; PG8_MMA(1, 0, At, B0); PG8_MMA(1, 1, At, B1); PG8_BAR; PG8_SCHED;
            PG8_LDB(B0, 1, 0); PG8_LDB(B1, 1, 1); PG8_SCHED; PG8_LDA(At, 1, 0); PG8_STAGE(PG8_SA(0, 1), a2 + hstep, voffA);
            PG8_WAIT_V(8); PG8_WAIT_L(0); PG8_BAR; PG8_MMA(0, 0, At, B0); PG8_MMA(0, 1, At, B1); PG8_BAR; PG8_SCHED;
            PG8_LDA(At, 1, 1); PG8_STAGE(PG8_SB(1, 0), b3, voffB); PG8_STAGE(PG8_SB(1, 1), b3 + hstep, voffB); PG8_STAGE(PG8_SA(1, 0), a3, voffA);
            PG8_WAIT_V(8); PG8_WAIT_L(0); PG8_BAR; PG8_MMA(1, 0, At, B0); PG8_MMA(1, 1, At, B1); PG8_BAR; PG8_SCHED;
            } else {
            PG8_LDB(B0, 0, 0); PG8_SCHED; PG8_LDA(At, 0, 0); PG8_STAGE(PG8_SA(1, 1), a1 + hstep, voffA);
            PG8_WAIT_L(8); PG8_BAR; PG8_WAIT_L(0); PG8_MMA(0, 0, At, B0); PG8_BAR; PG8_SCHED;
            PG8_LDB(B1, 0, 1); PG8_STAGE(PG8_SB(0, 0), b2, voffB);
            PG8_BAR; PG8_WAIT_L(0); PG8_MMA(0, 1, At, B1); PG8_BAR;
            PG8_LDA(At, 0, 1); PG8_STAGE(PG8_SA(0, 0), a2, voffA);
            PG8_BAR; PG8_WAIT_L(0); PG8_MMA(1, 0, At, B0); PG8_BAR; PG8_SCHED;
            PG8_STAGE(PG8_SB(0, 1), b2 + hstep, voffB);
            PG8_WAIT_V(6); PG8_BAR; PG8_MMA(1, 1, At, B1); PG8_BAR;
            PG8_LDB(B0, 1, 0); PG8_SCHED; PG8_LDA(At, 1, 0); PG8_STAGE(PG8_SA(0, 1), a2 + hstep, voffA);
            PG8_WAIT_L(8); PG8_BAR; PG8_WAIT_L(0); PG8_MMA(0, 0, At, B0); PG8_BAR; PG8_SCHED;
            PG8_LDB(B1, 1, 1); PG8_STAGE(PG8_SB(1, 0), b3, voffB);
            PG8_BAR; PG8_WAIT_L(0); PG8_MMA(0, 1, At, B1); PG8_BAR;
            PG8_LDA(At, 1, 1); PG8_STAGE(PG8_SA(1, 0), a3, voffA);
            PG8_BAR; PG8_WAIT_L(0); PG8_MMA(1, 0, At, B0); PG8_BAR; PG8_SCHED;
            PG8_STAGE(PG8_SB(1, 1), b3 + hstep, voffB);
            PG8_WAIT_V(6); PG8_BAR; PG8_MMA(1, 1, At, B1); PG8_BAR;
            }
        }
        if constexpr (ALIGN_EPI) { if (wr == 0) PG8_BAR; }
        if constexpr (!Epi::AFTER_DRAIN) { E(acc, cur, wr, wc, fr, fq); S.done(cur); }
        if (!has_next) break;
#pragma unroll
        for (int a = 0; a < 2; ++a)
#pragma unroll
            for (int b = 0; b < 2; ++b)
#pragma unroll
                for (int m = 0; m < 4; ++m)
#pragma unroll
                    for (int n = 0; n < 2; ++n) acc[a][b][m][n] = (f32x4){0.f, 0.f, 0.f, 0.f};
        cur = nxt; cA = nA; cB = nB; ++ui;
        if constexpr (ALIGN_EPI) { if (wr == 1) PG8_BAR; }
    }
    PG8_WAIT_V(0);
    if constexpr (!ALIGN_EPI) { if (wr == 0) PG8_BAR; }
    PG8_BAR;
    if constexpr (Epi::AFTER_DRAIN) { E.fused(acc, cur, wr, wc, fr, fq, lds, wid, lane); S.done(cur); }
#undef PG8_SA
#undef PG8_SB
#undef PG8_STAGE
#undef PG8_LDA
#undef PG8_LDB
#undef PG8_MMA
#undef PG8_WAIT_V
#undef PG8_WAIT_L
#undef PG8_BAR
#undef PG8_SCHED
}
}
constexpr int NWAVES = 8;
#ifndef MK_PER_PHASE
#define MK_PER_PHASE 0
#endif
#ifndef GLA_OLD_FOLD
#define GLA_OLD_FOLD 0
#endif
#ifndef GLA_OLD67
#define GLA_OLD67 0
#endif
#ifndef GLA_QK_OLD
#define GLA_QK_OLD 0
#endif
#ifndef GLA_SEQ_SCAN
#define GLA_SEQ_SCAN 0
#endif
#ifndef NAIVE_GEMM_MASK
#define NAIVE_GEMM_MASK 0
#endif
constexpr int T_ = 16384, D_ = 1024, S_ = 4096, INW = 2448, INP = 2560, NROWS_PAD = 36864;
constexpr float EPS_ = 1e-6f;
constexpr int ZC_CVV = 0, ZC_CVG = 256, ZC_LRX = 512, ZC_LRY = 896, ZC_Q = 1280, ZC_K = 1472, ZC_V = 1664, ZC_GLR = 2048, ZC_OG = 2064;
constexpr size_t MiB = 1u << 20;
constexpr size_t WS_CTL = 0, CTL_ZERO_BYTES = 1 * MiB;
constexpr size_t WS_MISC = 1 * MiB, MISC_STRIDE = 8 * MiB;
constexpr size_t WS_WIN = 17 * MiB, WS_WOUT = 27 * MiB, WS_WGU = 31 * MiB, WS_WD = 95 * MiB;
constexpr size_t WS_A0 = 127 * MiB;
constexpr size_t WS_A1 = 207 * MiB;
constexpr size_t WS_A2 = 243 * MiB;
constexpr size_t WS_END = 275 * MiB;
constexpr size_t MO_LRU = 262144, MO_GLA = 1310720, MO_TOKE = 6291456, MO_TOKW = 6422528, MO_TOKR = 6553600, MO_TOKP = 6684672, MO_BCNT = 6815744, MO_PRE = 6832128, MO_ROWW = 6848512;
constexpr int GLA_AGG = 48 + 48 * 96;
constexpr int CW_BAR = 4096;
constexpr int RING_BYTES = 131072, LDSCTL_OFF = 139264, MISC_OFF = LDSCTL_OFF + 320, LDS_BYTES = 147456;

#define GAS __attribute__((address_space(1)))
#define LAS __attribute__((address_space(3)))
typedef unsigned short bf16;
typedef unsigned v4u __attribute__((ext_vector_type(4)));
typedef unsigned v2u __attribute__((ext_vector_type(2)));
typedef float f32x4 __attribute__((ext_vector_type(4)));
typedef short bf16x8 __attribute__((ext_vector_type(8)));
typedef GAS unsigned gu32;
#define RLX_AGENT __ATOMIC_RELAXED, __HIP_MEMORY_SCOPE_AGENT
#define LDS_WAIT() asm volatile("s_waitcnt lgkmcnt(0)" ::: "memory")
#define VM_WAIT() asm volatile("s_waitcnt vmcnt(0)" ::: "memory")
__device__ __forceinline__ float bf2f(unsigned short h) { return __uint_as_float(((unsigned)h) << 16); }
__device__ __forceinline__ unsigned pk2(float lo, float hi) { return pg8::cvt_pk_bf16(lo, hi); }
__device__ __forceinline__ unsigned short f2bf(float f) { return (unsigned short)(pg8::cvt_pk_bf16(f, 0.f) & 0xffffu); }
__device__ __forceinline__ float lo_f(unsigned w) { return __uint_as_float(w << 16); }
__device__ __forceinline__ float hi_f(unsigned w) { return __uint_as_float(w & 0xffff0000u); }
template <int CTRL, int ROWMASK = 0xf> __device__ __forceinline__ float dpp_mov0(float v) { return __builtin_bit_cast(float, __builtin_amdgcn_update_dpp(0, __builtin_bit_cast(int, v), CTRL, ROWMASK, 0xf, false)); }
__device__ __forceinline__ float wave_sum(float v) {
    v += dpp_mov0<0xB1>(v);
    v += dpp_mov0<0x4E>(v);
    v += dpp_mov0<0x141>(v);
    v += dpp_mov0<0x140>(v);
    v += dpp_mov0<0x142, 0xa>(v);
    v += dpp_mov0<0x143, 0xc>(v);
    return __builtin_bit_cast(float, __builtin_amdgcn_readlane(__builtin_bit_cast(int, v), 63));
}
__device__ __forceinline__ float fexp(float v) { return __builtin_amdgcn_exp2f(v * 1.4426950408889634f); }
__device__ __forceinline__ float sigm_fast(float v) { return __builtin_amdgcn_rcpf(1.0f + __builtin_amdgcn_exp2f(v * -1.4426950408889634f)); }
__device__ __forceinline__ float sigm(float v) { return 1.0f / (1.0f + __expf(-v)); }
#define XB_TMO      128
#define XB_XCNT(j)  (256  + 64 * (j))
#define XB_XSUB(j)  (1280 + 64 * (j))
#define XB_XGEN(j)  (2304 + 64 * (j))
#define XB_TOP      3328
#define XB_TOPGEN   3392
#define XCD_BAR_WORDS 3456
#define XB_SPIN_CAP (1u << 18)

__device__ __forceinline__ unsigned xb_ld(unsigned* p)              { return __hip_atomic_load(p, __ATOMIC_RELAXED, __HIP_MEMORY_SCOPE_AGENT); }
__device__ __forceinline__ unsigned xb_add(unsigned* p, unsigned v) { return __hip_atomic_fetch_add(p, v, __ATOMIC_RELAXED, __HIP_MEMORY_SCOPE_AGENT); }
__device__ __forceinline__ unsigned xb_xcc_id() { return (unsigned)__builtin_amdgcn_s_getreg((3 << 11) | 20) & 0xFu; }
#define XB_SPIN(cond, bar) do { unsigned _sp = 0; while (cond) { __builtin_amdgcn_s_sleep(1); \
    if ((++_sp & 255u) == 0u) { if (xb_ld(&(bar)[XB_TMO])) break; if (_sp > XB_SPIN_CAP) { atomicAdd(&(bar)[XB_TMO], 1u); break; } } } } while (0)

struct XcdBarrier {
    unsigned* bar; unsigned x;
    volatile LAS unsigned* st;
};

__device__ __forceinline__ XcdBarrier xcd_barrier_post(unsigned* bar, volatile LAS unsigned* st) {
    XcdBarrier b; b.bar = bar; b.x = xb_xcc_id(); b.st = st;
    if (threadIdx.x == 0) (void)xb_add(&bar[XB_XCNT(b.x)], 1u);
    return b;
}
__device__ __forceinline__ void xcd_barrier_complete(unsigned* bar, unsigned x, unsigned& nloc, unsigned& nx) {
    const unsigned G = gridDim.x * gridDim.y * gridDim.z;
    unsigned sum, cnt, mine, sp = 0u;
    for (;;) {
        sum = 0u; cnt = 0u; mine = 0u;
#pragma unroll
        for (unsigned j = 0; j < 16; ++j) { const unsigned c = xb_ld(&bar[XB_XCNT(j)]); sum += c; cnt += (c > 0u) ? 1u : 0u; mine = (j == x) ? c : mine; }
        if (sum == G) break;
        __builtin_amdgcn_s_sleep(1);
        if ((++sp & 255u) == 0u) { if (xb_ld(&bar[XB_TMO])) break; if (sp > XB_SPIN_CAP) { atomicAdd(&bar[XB_TMO], 1u); break; } }
    }
    nloc = mine > 0u ? mine : 1u; nx = cnt > 0u ? cnt : 1u;
}

__device__ __forceinline__ void xcd_barrier(const XcdBarrier& b) {
    asm volatile("s_waitcnt vmcnt(0)" ::: "memory");
    __syncthreads();
    if (threadIdx.x == 0) {
        unsigned* bar = b.bar;
        __builtin_amdgcn_s_waitcnt(0);
        unsigned nloc = b.st[0], nx = b.st[1];
        if (nloc == 0u) { xcd_barrier_complete(bar, b.x, nloc, nx); b.st[0] = nloc; b.st[1] = nx; }
        const unsigned old = xb_add(&bar[XB_XSUB(b.x)], 1u);
        const unsigned gen = old / nloc;
        if (old + 1u == (gen + 1u) * nloc) {
            __builtin_amdgcn_fence(__ATOMIC_RELEASE, "agent");
            asm volatile("s_waitcnt vmcnt(0)" ::: "memory");
            const unsigned og = xb_add(&bar[XB_TOP], 1u);
            const unsigned tg = og / nx;
            if (og + 1u == (tg + 1u) * nx) xb_add(&bar[XB_TOPGEN], 1u);
            else XB_SPIN(xb_ld(&bar[XB_TOPGEN]) == tg, bar);
            __builtin_amdgcn_fence(__ATOMIC_ACQUIRE, "agent");
            xb_add(&bar[XB_XGEN(b.x)], 1u);
            asm volatile("s_waitcnt vmcnt(0)" ::: "memory");
        } else {
            XB_SPIN(xb_ld(&bar[XB_XGEN(b.x)]) == gen, bar);
            __builtin_amdgcn_fence(__ATOMIC_ACQUIRE, "agent");
            asm volatile("s_waitcnt vmcnt(0)" ::: "memory");
        }
    }
    __syncthreads();
}
struct Args { const float* in[30]; float* out; unsigned char* ws; int ph_lo, ph_hi, li, pad; };
struct Ctx { LAS unsigned char* lds; int tid, lane, wave, vcu, G, bx; };
__device__ __forceinline__ Ctx mkctx(LAS unsigned char* lds) {
    Ctx X; int tid = threadIdx.x; asm volatile("" : "+v"(tid)); int bx = blockIdx.x, G = gridDim.x; asm volatile("" : "+s"(bx), "+s"(G));
    X.lds = lds; X.tid = tid; X.lane = tid & 63; X.wave = __builtin_amdgcn_readfirstlane(tid >> 6); X.G = G; X.bx = bx; X.vcu = (G % 8 == 0) ? (bx % 8) * (G / 8) + bx / 8 : bx; return X;
}
#define UNIT_CTX(X0) Ctx X = (X0); { int t_ = (X0).tid; asm volatile("" : "+v"(t_)); X.tid = t_; X.lane = t_ & 63; X.wave = __builtin_amdgcn_readfirstlane(t_ >> 6); } int zo = 0; asm volatile("" : "+s"(zo))
#define AIN(i) (a.in[i] + zo)
enum { I_X = 0, I_C, I_WADA, I_BADA, I_GMIX, I_WIN, I_CDW, I_CDB, I_CLG, I_CLB, I_LCW, I_LCB, I_LWA, I_LBA, I_LWI, I_LBI, I_LAM, I_GWG, I_GBG, I_GNG, I_WOUT, I_GFFN, I_WRG, I_BRG, I_WRE, I_BRE,
       I_WG, I_WU, I_WDN, I_GFIN };
#define WSP(T, off) ((T*)(a.ws + zo + (off)))
#define MISCP(T, l, off) ((T*)(a.ws + zo + WS_MISC + (size_t)(l) * MISC_STRIDE + (off)))
#define MODP(a) ((float*)((a).ws + zo + WS_MISC))
#define BSYNC() __syncthreads()

__device__ __forceinline__ void transpose_item(const float* W, int N, int k0, int n0, bf16* WT, int ldk, int dst_row0, LAS float* scr, int lane) {
    const int kq = lane >> 4, n4 = (lane & 15) * 4;
    f32x4 v[16];
#pragma unroll
    for (int i = 0; i < 16; ++i) { const int k = 4 * i + kq; v[i] = (n0 + n4 < N) ? *(const f32x4*)(W + (size_t)(k0 + k) * N + n0 + n4) : (f32x4){0.f, 0.f, 0.f, 0.f}; }
#pragma unroll
    for (int i = 0; i < 16; ++i) { const int k = 4 * i + kq; LAS float* s = scr + k * 65 + n4; s[0] = v[i].x; s[1] = v[i].y; s[2] = v[i].z; s[3] = v[i].w; }
    LDS_WAIT(); asm volatile("" ::: "memory");
    const int c = lane & 7;
#pragma unroll
    for (int j = 0; j < 8; ++j) { const int n = (lane >> 3) + 8 * j; const LAS float* s = scr + (8 * c) * 65 + n;
        v4u o; o.x = pk2(s[0], s[65]); o.y = pk2(s[130], s[195]); o.z = pk2(s[260], s[325]); o.w = pk2(s[390], s[455]);
        *(v4u*)(WT + (size_t)(dst_row0 + n) * ldk + k0 + 8 * c) = o; }
    LDS_WAIT(); asm volatile("" ::: "memory");
}
__device__ __forceinline__ void p0_prologue(const Args& a, const Ctx& X) {
    const int zo = 0;
    for (int u = X.vcu; u < 192; u += X.G) {
        const int l = u / 96, n0 = (u % 96) * 64;
        LAS float* cact = (LAS float*)(X.lds); LAS float* red = (LAS float*)(X.lds + 16384);
        for (int i = X.tid; i < 4096; i += 512) { const float v = a.in[I_C][i]; cact[i] = v * sigm(v); }
        BSYNC();
        const int cq = X.tid & 15, kc = X.tid >> 4;
        f32x4 acc[4] = {{0.f, 0.f, 0.f, 0.f}, {0.f, 0.f, 0.f, 0.f}, {0.f, 0.f, 0.f, 0.f}, {0.f, 0.f, 0.f, 0.f}};
        const float* wp = a.in[I_WADA] + ((size_t)l * 1024 + kc * 32) * 6144 + n0 + cq * 4;
#pragma unroll 8
        for (int kk = 0; kk < 32; ++kk) { const f32x4 w = *(const f32x4*)(wp + (size_t)kk * 6144);
#pragma unroll
            for (int b = 0; b < 4; ++b) acc[b] += w * cact[b * 1024 + kc * 32 + kk]; }
#pragma unroll
        for (int b = 0; b < 4; ++b) *(LAS f32x4*)(red + (kc * 4 + b) * 64 + cq * 4) = acc[b];
        BSYNC();
        if (X.tid < 256) { const int b = X.tid >> 6, col = X.tid & 63; float s = 0.f;
            for (int k2 = 0; k2 < 32; ++k2) s += red[(k2 * 4 + b) * 64 + col];
            MODP(a)[(size_t)(l * 4 + b) * 6144 + n0 + col] = s + a.in[I_BADA][l * 6144 + n0 + col]; }
        BSYNC();
    }
    for (int idx = X.vcu * 512 + X.tid; idx < 2 * 49152; idx += X.G * 512) { const int l = idx / 49152, r = idx % 49152, jj = r & 7, ln = (r >> 3) & 63, ks = (r >> 9) & 1, jt = (r >> 10) & 3, gate = (r >> 12) & 1, h = r >> 13;
        const float* W = gate ? a.in[I_LWI] : a.in[I_LWA];
        ((bf16*)(a.ws + WS_MISC + (size_t)l * MISC_STRIDE + 7340032))[r] = f2bf(W[((size_t)(l * 6 + h) * 64 + ks * 32 + 8 * (ln >> 4) + jj) * 64 + jt * 16 + (ln & 15)]); }
    LAS float* scr = (LAS float*)(X.lds + X.wave * 16640);
    const int gw = X.vcu * NWAVES + X.wave, NGW = X.G * NWAVES;
    constexpr int NI_IN = 2 * 16 * 40, NI_OUT = 2 * 16 * 16, NI_E = 32 * 128;
    for (int it = gw; it < NI_IN + NI_OUT + 3 * NI_E; it += NGW) {
        int r = it;
        if (r < NI_IN) { const int l = r / 640; r %= 640; const int kt = r / 40, nt = r % 40;
            transpose_item(a.in[I_WIN] + (size_t)l * 1024 * INW, INW, kt * 64, nt * 64, WSP(bf16, WS_WIN) + (size_t)l * INP * 1024, 1024, nt * 64, scr, X.lane); continue; }
        r -= NI_IN;
        if (r < NI_OUT) { const int l = r / 256; r %= 256; const int kt = r / 16, nt = r % 16;
            transpose_item(a.in[I_WOUT] + (size_t)l * 1048576, 1024, kt * 64, nt * 64, WSP(bf16, WS_WOUT) + (size_t)l * 1048576, 1024, nt * 64, scr, X.lane); continue; }
        r -= NI_OUT;
        if (r < NI_E) { const int le = r / 128; r %= 128; const int kt = r / 8, n0 = (r % 8) * 64;
            transpose_item(a.in[I_WG] + (size_t)le * 524288, 512, kt * 64, n0, WSP(bf16, WS_WGU) + (size_t)le * 1048576, 1024, (n0 >> 7) * 256 + (n0 & 127), scr, X.lane); continue; }
        r -= NI_E;
        if (r < NI_E) { const int le = r / 128; r %= 128; const int kt = r / 8, n0 = (r % 8) * 64;
            transpose_item(a.in[I_WU] + (size_t)le * 524288, 512, kt * 64, n0, WSP(bf16, WS_WGU) + (size_t)le * 1048576, 1024, (n0 >> 7) * 256 + 128 + (n0 & 127), scr, X.lane); continue; }
        r -= NI_E;
        { const int le = r / 128; r %= 128; const int kt = r / 16, nt = r % 16;
            transpose_item(a.in[I_WDN] + (size_t)le * 524288, 1024, kt * 64, nt * 64, WSP(bf16, WS_WD) + (size_t)le * 524288, 512, nt * 64, scr, X.lane); }
    }
}

template <int MODE> __device__ __forceinline__ void row_phase(const Args& a, const Ctx& X, int l) {
    const int zo = 0;
    const int gw = X.vcu * NWAVES + X.wave, NGW = X.G * NWAVES;
    const int lp = (MODE == 2) ? 1 : l - 1;
    const float* xin = (MODE == 0) ? a.in[I_X] : a.out;
    const bf16* Y = WSP(bf16, WS_A0); bf16* H = WSP(bf16, WS_A2);
    for (int m = gw; m < T_; m += NGW) {
        const int b = m >> 12;
        f32x4 v[4];
#pragma unroll
        for (int j = 0; j < 4; ++j) v[j] = ((const f32x4*)(xin + (size_t)m * 1024))[X.lane + 64 * j];
        if (MODE >= 1) {
            const int* tp = MISCP(int, lp, MO_TOKP); const int p0 = tp[2 * m], p1 = tp[2 * m + 1];
            const float* gt = MODP(a) + ((size_t)(lp * 4 + b) * 6 + 5) * 1024;
#pragma unroll
            for (int j = 0; j < 4; ++j) { const v2u y0 = ((const v2u*)(Y + (size_t)p0 * 1024))[X.lane + 64 * j], y1 = ((const v2u*)(Y + (size_t)p1 * 1024))[X.lane + 64 * j];
                const f32x4 g = ((const f32x4*)gt)[X.lane + 64 * j];
                const f32x4 ys = {lo_f(y0.x) + lo_f(y1.x), hi_f(y0.x) + hi_f(y1.x), lo_f(y0.y) + lo_f(y1.y), hi_f(y0.y) + hi_f(y1.y)};
                v[j] += g * ys; }
            if (MODE == 1) {
#pragma unroll
                for (int j = 0; j < 4; ++j) ((f32x4*)(a.out + (size_t)m * 1024))[X.lane + 64 * j] = v[j]; }
        }
        float ss = 0.f;
#pragma unroll
        for (int j = 0; j < 4; ++j) ss += (v[j].x * v[j].x + v[j].y * v[j].y) + (v[j].z * v[j].z + v[j].w * v[j].w);
        const float rstd = 1.0f / sqrtf(wave_sum(ss) * (1.0f / 1024.0f) + EPS_);
        if (MODE == 2) {
#pragma unroll
            for (int j = 0; j < 4; ++j) { const f32x4 g = ((const f32x4*)a.in[I_GFIN])[X.lane + 64 * j]; ((f32x4*)(a.out + (size_t)m * 1024))[X.lane + 64 * j] = v[j] * rstd * g; }
        } else {
            const float* md = MODP(a) + (size_t)(l * 4 + b) * 6144;
#pragma unroll
            for (int j = 0; j < 4; ++j) { const f32x4 g = ((const f32x4*)(a.in[I_GMIX] + l * 1024))[X.lane + 64 * j], sh = ((const f32x4*)md)[X.lane + 64 * j], sc = ((const f32x4*)(md + 1024))[X.lane + 64 * j];
                const f32x4 h = v[j] * rstd * g * (sc + 1.0f) + sh;
                v2u o; o.x = pk2(h.x, h.y); o.y = pk2(h.z, h.w); ((v2u*)(H + (size_t)m * 1024))[X.lane + 64 * j] = o; }
        }
    }
}

__device__ __forceinline__ void conv_unit(const Args& a, const Ctx& X0, int l, int u) {
    UNIT_CTX(X0);
    const int b = u >> 6, t0 = (u & 63) * 64; const size_t m0 = (size_t)u * 64;
    const bf16* Z = WSP(bf16, WS_A0); bf16* MX = WSP(bf16, WS_A1);
    LAS float* U = (LAS float*)X.lds;
    for (int idx = X.tid; idx < 94 * 32; idx += 512) {
        const int r = idx >> 5, c8 = (idx & 31) * 8, t = t0 - 30 + r;
        f32x4 o0 = {0.f, 0.f, 0.f, 0.f}, o1 = {0.f, 0.f, 0.f, 0.f};
        if (t >= 0) { const bf16* zr = Z + ((size_t)b * S_ + t) * INP; const v4u vv = *(const v4u*)(zr + ZC_CVV + c8), gg = *(const v4u*)(zr + ZC_CVG + c8);
            o0.x = lo_f(vv.x) * sigm(lo_f(gg.x)); o0.y = hi_f(vv.x) * sigm(hi_f(gg.x)); o0.z = lo_f(vv.y) * sigm(lo_f(gg.y)); o0.w = hi_f(vv.y) * sigm(hi_f(gg.y));
            o1.x = lo_f(vv.z) * sigm(lo_f(gg.z)); o1.y = hi_f(vv.z) * sigm(hi_f(gg.z)); o1.z = lo_f(vv.w) * sigm(lo_f(gg.w)); o1.w = hi_f(vv.w) * sigm(hi_f(gg.w)); }
        *(LAS f32x4*)(U + r * 256 + c8) = o0; *(LAS f32x4*)(U + r * 256 + c8 + 4) = o1;
    }
    BSYNC();
    const int c = X.tid & 255, half = X.tid >> 8;
    float outv[32];
    {
        float wgt[31];
#pragma unroll
        for (int j = 0; j < 31; ++j) wgt[j] = AIN(I_CDW)[(l * 31 + j) * 256 + c];
        const float bias = AIN(I_CDB)[l * 256 + c];
#pragma unroll
        for (int g = 0; g < 4; ++g) {
            float win[38];
#pragma unroll
            for (int i = 0; i < 38; ++i) win[i] = U[(half * 32 + g * 8 + i) * 256 + c];
#pragma unroll
            for (int o = 0; o < 8; ++o) { float s = bias;
#pragma unroll
                for (int j = 0; j < 31; ++j) s += wgt[j] * win[o + j];
                outv[g * 8 + o] = s; }
        }
    }
    BSYNC();
#pragma unroll
    for (int i = 0; i < 32; ++i) U[(half * 32 + i) * 256 + c] = outv[i];
    BSYNC();
    {
        const f32x4 g = ((const f32x4*)(AIN(I_CLG) + l * 256))[X.lane], be = ((const f32x4*)(AIN(I_CLB) + l * 256))[X.lane];
        for (int i = 0; i < 8; ++i) { const int t = X.wave * 8 + i;
            const f32x4 v = *(LAS f32x4*)(U + t * 256 + X.lane * 4);
            const float mu = wave_sum((v.x + v.y) + (v.z + v.w)) * (1.0f / 256.0f);
            const f32x4 d = v - mu;
            const float var = wave_sum((d.x * d.x + d.y * d.y) + (d.z * d.z + d.w * d.w)) * (1.0f / 256.0f);
            const float rstd = 1.0f / sqrtf(var + EPS_);
            f32x4 y = d * rstd * g + be;
            y.x *= sigm(y.x); y.y *= sigm(y.y); y.z *= sigm(y.z); y.w *= sigm(y.w);
            v2u o; o.x = pk2(y.x, y.y); o.y = pk2(y.z, y.w);
            *(v2u*)(MX + (m0 + t) * 1024 + X.lane * 4) = o; }
    }
}

__device__ __forceinline__ float gelu_fast(float v) { const float t = 1.5957691216f * (v + 0.044715f * v * v * v); return v * sigm_fast(t); }
template <int CTRL> __device__ __forceinline__ float dpp_id(float idv, float v) { return __builtin_bit_cast(float, __builtin_amdgcn_update_dpp(__builtin_bit_cast(int, idv), __builtin_bit_cast(int, v), CTRL, 0xf, 0xf, false)); }
constexpr size_t MO_LPK = 7340032;
template <bool FULL> __device__ __forceinline__ void lru_unit(const Args& a, const Ctx& X0, int l, int u) {
    UNIT_CTX(X0);
    const int b = u >> 6, tile = u & 63, t0 = tile * 64; const size_t m0 = (size_t)u * 64;
    const bf16* Z = WSP(bf16, WS_A0); bf16* MX = WSP(bf16, WS_A1);
    float* AGG = MISCP(float, l, MO_LRU);
    const bf16* WPK = MISCP(bf16, l, MO_LPK);
    LAS bf16* XB = (LAS bf16*)X.lds;
    LAS bf16* GY = (LAS bf16*)(X.lds + 50176);
    LAS float* CIN = (LAS float*)(X.lds + 100352);
    if (X.lane < 48) {
        const int c = X.lane * 8, tw = t0 + X.wave * 8;
        v4u raw[11], yy[8];
#pragma unroll
        for (int rr = 0; rr < 11; ++rr) { const int tt = tw - 3 + rr; raw[rr] = (tt >= 0) ? *(const v4u*)(Z + ((size_t)b * S_ + tt) * INP + ZC_LRX + c) : (v4u){0u, 0u, 0u, 0u}; }
        if (FULL) {
#pragma unroll
            for (int j = 0; j < 8; ++j) yy[j] = *(const v4u*)(Z + ((size_t)b * S_ + tw + j) * INP + ZC_LRY + c); }
        f32x4 w0[4], w1[4];
#pragma unroll
        for (int k = 0; k < 4; ++k) { w0[k] = *(const f32x4*)(AIN(I_LCW) + (l * 4 + k) * 384 + c); w1[k] = *(const f32x4*)(AIN(I_LCW) + (l * 4 + k) * 384 + c + 4); }
        const f32x4 b0 = *(const f32x4*)(AIN(I_LCB) + l * 384 + c), b1 = *(const f32x4*)(AIN(I_LCB) + l * 384 + c + 4);
#pragma unroll
        for (int j = 0; j < 8; ++j) { f32x4 s0 = b0, s1 = b1;
#pragma unroll
            for (int k = 0; k < 4; ++k) { const v4u xv = raw[j + k];
                s0 += w0[k] * (f32x4){lo_f(xv.x), hi_f(xv.x), lo_f(xv.y), hi_f(xv.y)}; s1 += w1[k] * (f32x4){lo_f(xv.z), hi_f(xv.z), lo_f(xv.w), hi_f(xv.w)}; }
            v4u o; o.x = pk2(s0.x, s0.y); o.y = pk2(s0.z, s0.w); o.z = pk2(s1.x, s1.y); o.w = pk2(s1.z, s1.w);
            *(LAS v4u*)(XB + (X.wave * 8 + j) * 392 + c) = o;
            if (FULL) { const v4u yv = yy[j]; v4u g;
                g.x = pk2(gelu_fast(lo_f(yv.x)), gelu_fast(hi_f(yv.x))); g.y = pk2(gelu_fast(lo_f(yv.y)), gelu_fast(hi_f(yv.y)));
                g.z = pk2(gelu_fast(lo_f(yv.z)), gelu_fast(hi_f(yv.z))); g.w = pk2(gelu_fast(lo_f(yv.w)), gelu_fast(hi_f(yv.w)));
                *(LAS v4u*)(GY + (X.wave * 8 + j) * 392 + c) = g; } }
    }
    if (FULL && X.tid < 384) {
        float cr = 0.f; const float* ag = AGG + ((size_t)(b * 64) * 384 + X.tid) * 2;
        int j = 0;
        for (; j + 16 <= tile; j += 16) { float2 ph[16];
#pragma unroll
            for (int i = 0; i < 16; ++i) ph[i] = *(const float2*)(ag + (size_t)(j + i) * 768);
#pragma unroll
            for (int i = 0; i < 16; ++i) cr = ph[i].x * cr + ph[i].y; }
        { float2 ph[16];
#pragma unroll
          for (int i = 0; i < 16; ++i) ph[i] = (j + i < tile) ? *(const float2*)(ag + (size_t)(j + i) * 768) : make_float2(1.f, 0.f);
#pragma unroll
          for (int i = 0; i < 16; ++i) cr = ph[i].x * cr + ph[i].y; }
        CIN[X.tid] = cr; }
    BSYNC();
    const int col = X.lane & 15, q = X.lane >> 4;
#pragma unroll
    for (int ii = 0; ii < 3; ++ii) {
        const int it = X.wave + 8 * ii, h = it >> 2, jt = it & 3, c = h * 64 + jt * 16 + 4 * q;
        const bf16* wp = WPK + (size_t)((h * 2) * 4 + jt) * 1024 + X.lane * 8;
        const bf16x8 fa0 = *(const bf16x8*)(wp), fa1 = *(const bf16x8*)(wp + 512), fi0 = *(const bf16x8*)(wp + 4096), fi1 = *(const bf16x8*)(wp + 4096 + 512);
        const f32x4 ba = *(const f32x4*)(AIN(I_LBA) + l * 384 + c), bi = *(const f32x4*)(AIN(I_LBI) + l * 384 + c), lam = *(const f32x4*)(AIN(I_LAM) + l * 384 + c);
        f32x4 c1;
#pragma unroll
        for (int r = 0; r < 4; ++r) c1[r] = -8.0f * 1.4426950408889634f * 0.6931471805599453f * __builtin_amdgcn_logf(1.0f + __builtin_amdgcn_exp2f(-1.4426950408889634f * lam[r]));
        f32x4 accA[4], accI[4];
#pragma unroll
        for (int tt = 0; tt < 4; ++tt) { accA[tt] = (f32x4){0.f, 0.f, 0.f, 0.f}; accI[tt] = (f32x4){0.f, 0.f, 0.f, 0.f};
            const bf16x8 x0 = *(const LAS bf16x8*)(XB + (tt * 16 + col) * 392 + h * 64 + 8 * q), x1 = *(const LAS bf16x8*)(XB + (tt * 16 + col) * 392 + h * 64 + 32 + 8 * q);
            accA[tt] = __builtin_amdgcn_mfma_f32_16x16x32_bf16(fa0, x0, accA[tt], 0, 0, 0); accA[tt] = __builtin_amdgcn_mfma_f32_16x16x32_bf16(fa1, x1, accA[tt], 0, 0, 0);
            accI[tt] = __builtin_amdgcn_mfma_f32_16x16x32_bf16(fi0, x0, accI[tt], 0, 0, 0); accI[tt] = __builtin_amdgcn_mfma_f32_16x16x32_bf16(fi1, x1, accI[tt], 0, 0, 0); }
        f32x4 carry = FULL ? *(const LAS f32x4*)(CIN + c) : (f32x4){0.f, 0.f, 0.f, 0.f};
        f32x4 lsum = {0.f, 0.f, 0.f, 0.f};
#pragma unroll
        for (int tt = 0; tt < 4; ++tt) { const int t = tt * 16 + col;
            const v2u xw = *(const LAS v2u*)(XB + t * 392 + c); const f32x4 xb = {lo_f(xw.x), hi_f(xw.x), lo_f(xw.y), hi_f(xw.y)};
            f32x4 hv;
#pragma unroll
            for (int r = 0; r < 4; ++r) {
                const float rg = sigm_fast(accA[tt][r] + ba[r]), ig = sigm_fast(accI[tt][r] + bi[r]);
                const float la2 = c1[r] * rg; float A = __builtin_amdgcn_exp2f(la2); float U = __builtin_amdgcn_sqrtf(fmaxf(1.0f - A * A, 0.f)) * (ig * xb[r]);
                lsum[r] += la2;
                { const float Ap = dpp_id<0x111>(1.f, A), Up = dpp_id<0x111>(0.f, U); U = A * Up + U; A = A * Ap; }
                { const float Ap = dpp_id<0x112>(1.f, A), Up = dpp_id<0x112>(0.f, U); U = A * Up + U; A = A * Ap; }
                { const float Ap = dpp_id<0x114>(1.f, A), Up = dpp_id<0x114>(0.f, U); U = A * Up + U; A = A * Ap; }
                { const float Ap = dpp_id<0x118>(1.f, A), Up = dpp_id<0x118>(0.f, U); U = A * Up + U; A = A * Ap; }
                const float hh = A * carry[r] + U; hv[r] = hh;
                carry[r] = __builtin_bit_cast(float, __builtin_amdgcn_ds_bpermute(((X.lane | 15) << 2), __builtin_bit_cast(int, hh)));
            }
            if (FULL) { const v2u gw = *(const LAS v2u*)(GY + t * 392 + c);
                v2u o; o.x = pk2(hv[0] * lo_f(gw.x), hv[1] * hi_f(gw.x)); o.y = pk2(hv[2] * lo_f(gw.y), hv[3] * hi_f(gw.y));
                *(LAS v2u*)(GY + t * 392 + c) = o; }
        }
        if (!FULL) {
#pragma unroll
            for (int r = 0; r < 4; ++r) { float s = lsum[r]; s += dpp_mov0<0xB1>(s); s += dpp_mov0<0x4E>(s); s += dpp_mov0<0x141>(s); s += dpp_mov0<0x140>(s); lsum[r] = __builtin_amdgcn_exp2f(s); }
            if (col == 0) { float* ag = AGG + ((size_t)u * 384 + c) * 2;
                *(f32x4*)(ag) = (f32x4){lsum[0], carry[0], lsum[1], carry[1]}; *(f32x4*)(ag + 4) = (f32x4){lsum[2], carry[2], lsum[3], carry[3]}; }
        }
    }
    if (FULL) {
        BSYNC();
#pragma unroll
        for (int i = 0; i < 6; ++i) { const int idx = X.tid + 512 * i, t = idx / 48, ch = idx % 48;
            *(v4u*)(MX + (m0 + t) * 1024 + 256 + ch * 8) = *(const LAS v4u*)(GY + t * 392 + ch * 8); }
    }
}

constexpr int GO_LG = 0, GO_QIN = 12544, GO_KIN = 21760, GO_KDT = 30976, GO_VT = 37888, GO_SC = 51712, GO_ST = 60928, GO_OB = 74752, GO_GL = 100352, GO_BL = 104704, GO_LS = 104960, GO_WG = 105216, GO_BG = 108288, GO_SSQ = 108544;
template <bool FULL> __device__ __forceinline__ void gla_unit(const Args& a, const Ctx& X0, int l, int u) {
    UNIT_CTX(X0);
    const int b = u >> 6, h = (u >> 4) & 3, sc = u & 15;
    const bf16* Z = WSP(bf16, WS_A0); bf16* MX = WSP(bf16, WS_A1);
    float* AGG = MISCP(float, l, MO_GLA);
    LAS float* LGT = (LAS float*)(X.lds + GO_LG); LAS bf16* QIN = (LAS bf16*)(X.lds + GO_QIN); LAS bf16* KIN = (LAS bf16*)(X.lds + GO_KIN); LAS bf16* KDT = (LAS bf16*)(X.lds + GO_KDT);
    LAS bf16* VT = (LAS bf16*)(X.lds + GO_VT); LAS bf16* SC = (LAS bf16*)(X.lds + GO_SC); LAS bf16* ST = (LAS bf16*)(X.lds + GO_ST); LAS float* OB = (LAS float*)(X.lds + GO_OB);
    LAS float* GL = (LAS float*)(X.lds + GO_GL); LAS float* BL = (LAS float*)(X.lds + GO_BL); LAS float* LS = (LAS float*)(X.lds + GO_LS); LAS float* WG = (LAS float*)(X.lds + GO_WG);
    LAS float* BG = (LAS float*)(X.lds + GO_BG); LAS float* SSQ = (LAS float*)(X.lds + GO_SSQ);
    const int col = X.lane & 15, q = X.lane >> 4;
    for (int i = X.tid; i < 16 * 48; i += 512) WG[i] = AIN(I_GWG)[(l * 16 + i / 48) * 192 + h * 48 + i % 48];
    if (X.tid < 48) { LS[X.tid] = 0.f; BG[X.tid] = AIN(I_GBG)[l * 192 + h * 48 + X.tid]; }
    if (FULL) { for (int i = X.tid; i < 64 * 16; i += 512) { const int r = i >> 4, cc = 48 + (i & 15); QIN[r * 72 + cc] = 0; KIN[r * 72 + cc] = 0; }
                for (int i = X.tid; i < 96 * 16; i += 512) { const int r = i >> 4, cc = 48 + (i & 15); ST[r * 72 + cc] = 0; } }
    const int kc = X.tid / 6, kd = X.tid % 6;
    const int vc0 = X.tid / 12, ve0 = X.tid % 12, vc1 = (X.tid + 512) / 12, ve1 = (X.tid + 512) % 12; const bool has1 = X.tid < 256;
    f32x4 gn0[2], gn1[2];
    if (FULL) { gn0[0] = *(const f32x4*)(AIN(I_GNG) + l * 384 + h * 96 + ve0 * 8); gn0[1] = *(const f32x4*)(AIN(I_GNG) + l * 384 + h * 96 + ve0 * 8 + 4);
                gn1[0] = *(const f32x4*)(AIN(I_GNG) + l * 384 + h * 96 + ve1 * 8); gn1[1] = *(const f32x4*)(AIN(I_GNG) + l * 384 + h * 96 + ve1 * 8 + 4); }
    f32x4 Sacc[3];
#pragma unroll
    for (int i = 0; i < 3; ++i) Sacc[i] = (f32x4){0.f, 0.f, 0.f, 0.f};
#if GLA_OLD_FOLD
    if (FULL) {
        for (int s2 = 0; s2 < sc; ++s2) { const float* ag = AGG + (size_t)((b * 4 + h) * 16 + s2) * GLA_AGG;
#pragma unroll
            for (int i = 0; i < 3; ++i) { const int ti = X.wave + 8 * i; if (ti < 18) { const int dt = ti / 6, et = ti % 6;
#pragma unroll
                for (int r = 0; r < 4; ++r) { const int d = dt * 16 + 4 * q + r; Sacc[i][r] = __expf(ag[d]) * Sacc[i][r] + ag[48 + d * 96 + et * 16 + col]; } } } }
    }
#else
    if (FULL) {
        const float* ag0 = AGG + (size_t)((b * 4 + h) * 16) * GLA_AGG;
        for (int s2 = 0; s2 < sc; s2 += 4) {
            f32x4 dv[4][3], sv[4][3];
#pragma unroll
            for (int k = 0; k < 4; ++k) { const float* ag = ag0 + (size_t)((s2 + k < sc) ? s2 + k : 0) * GLA_AGG;
#pragma unroll
                for (int i = 0; i < 3; ++i) { const int ti = X.wave + 8 * i; if (ti < 18) { const int dt = ti / 6, et = ti % 6;
                    dv[k][i] = *(const f32x4*)(ag + dt * 16 + 4 * q);
#pragma unroll
                    for (int r = 0; r < 4; ++r) sv[k][i][r] = ag[48 + (dt * 16 + 4 * q + r) * 96 + et * 16 + col]; } } }
#pragma unroll
            for (int k = 0; k < 4; ++k) if (s2 + k < sc) {
#pragma unroll
                for (int i = 0; i < 3; ++i) { const int ti = X.wave + 8 * i; if (ti < 18) {
#pragma unroll
                    for (int r = 0; r < 4; ++r) Sacc[i][r] = fexp(dv[k][i][r]) * Sacc[i][r] + sv[k][i][r]; } } }
        }
    }
#endif
    BSYNC();
    for (int ch = 0; ch < 4; ++ch) {
        const int t0 = sc * 256 + ch * 64; const size_t m0 = (size_t)b * S_ + t0;
        v4u kr = {0u, 0u, 0u, 0u}, qr = {0u, 0u, 0u, 0u}, og0 = {0u, 0u, 0u, 0u}, og1 = {0u, 0u, 0u, 0u}, vr0, vr1 = {0u, 0u, 0u, 0u}, gr = {0u, 0u, 0u, 0u};
        if (X.tid < 384) { kr = *(const v4u*)(Z + (m0 + kc) * INP + ZC_K + h * 48 + kd * 8); if (FULL) qr = *(const v4u*)(Z + (m0 + kc) * INP + ZC_Q + h * 48 + kd * 8); }
        vr0 = *(const v4u*)(Z + (m0 + vc0) * INP + ZC_V + h * 96 + ve0 * 8); if (has1) vr1 = *(const v4u*)(Z + (m0 + vc1) * INP + ZC_V + h * 96 + ve1 * 8);
        if (X.tid < 128) gr = *(const v4u*)(Z + (m0 + (X.tid >> 1)) * INP + ZC_GLR + (X.tid & 1) * 8);
        if (FULL) { og0 = *(const v4u*)(Z + (m0 + vc0) * INP + ZC_OG + h * 96 + ve0 * 8); if (has1) og1 = *(const v4u*)(Z + (m0 + vc1) * INP + ZC_OG + h * 96 + ve1 * 8); }
        if (X.tid < 128) { LAS float* g = GL + (X.tid >> 1) * 17 + (X.tid & 1) * 8;
            g[0] = lo_f(gr.x); g[1] = hi_f(gr.x); g[2] = lo_f(gr.y); g[3] = hi_f(gr.y); g[4] = lo_f(gr.z); g[5] = hi_f(gr.z); g[6] = lo_f(gr.w); g[7] = hi_f(gr.w); }
        { LAS bf16* vt = VT + (ve0 * 8) * 72 + vc0;
            vt[0] = (bf16)(vr0.x & 0xffffu); vt[72] = (bf16)(vr0.x >> 16); vt[144] = (bf16)(vr0.y & 0xffffu); vt[216] = (bf16)(vr0.y >> 16);
            vt[288] = (bf16)(vr0.z & 0xffffu); vt[360] = (bf16)(vr0.z >> 16); vt[432] = (bf16)(vr0.w & 0xffffu); vt[504] = (bf16)(vr0.w >> 16); }
        if (has1) { LAS bf16* vt = VT + (ve1 * 8) * 72 + vc1;
            vt[0] = (bf16)(vr1.x & 0xffffu); vt[72] = (bf16)(vr1.x >> 16); vt[144] = (bf16)(vr1.y & 0xffffu); vt[216] = (bf16)(vr1.y >> 16);
            vt[288] = (bf16)(vr1.z & 0xffffu); vt[360] = (bf16)(vr1.z >> 16); vt[432] = (bf16)(vr1.w & 0xffffu); vt[504] = (bf16)(vr1.w >> 16); }
        BSYNC();
#pragma unroll
        for (int i = 0; i < 6; ++i) { const int o = X.tid + 512 * i, c = o / 48, d = o % 48; float s = BG[d];
#pragma unroll
            for (int r = 0; r < 16; ++r) s += GL[c * 17 + r] * WG[r * 48 + d];
            const float ls = fminf(s, 0.f) - 0.6931471805599453f * __builtin_amdgcn_logf(1.0f + __builtin_amdgcn_exp2f(-1.4426950408889634f * fabsf(s)));
            LGT[d * 65 + c] = ls * 0.0625f; }
        BSYNC();
#if GLA_SEQ_SCAN
        if (X.tid < 48) { float s = 0.f; for (int c = 0; c < 64; ++c) { s += LGT[X.tid * 65 + c]; LGT[X.tid * 65 + c] = s; } BL[X.tid] = s; }
#else
#pragma unroll
        for (int i = 0; i < 6; ++i) { const int d = X.wave * 6 + i; float v = LGT[d * 65 + X.lane];
            v += dpp_mov0<0x111>(v); v += dpp_mov0<0x112>(v); v += dpp_mov0<0x114>(v); v += dpp_mov0<0x118>(v);
            v += dpp_mov0<0x142, 0xa>(v); v += dpp_mov0<0x143, 0xc>(v);
            LGT[d * 65 + X.lane] = v; if (X.lane == 63) BL[d] = v; }
#endif
        BSYNC();
        if (X.tid < 384) {
            float kf[8] = {lo_f(kr.x), hi_f(kr.x), lo_f(kr.y), hi_f(kr.y), lo_f(kr.z), hi_f(kr.z), lo_f(kr.w), hi_f(kr.w)};
            float qf[8] = {lo_f(qr.x), hi_f(qr.x), lo_f(qr.y), hi_f(qr.y), lo_f(qr.z), hi_f(qr.z), lo_f(qr.w), hi_f(qr.w)};
            float qo[8], ko[8];
#pragma unroll
            for (int i = 0; i < 8; ++i) { const int d = kd * 8 + i; const float bc = LGT[d * 65 + kc], bl = BL[d];
                KDT[d * 72 + kc] = f2bf(kf[i] * fexp(bl - bc));
                if (FULL) { qo[i] = qf[i] * 0.14433756729740643f * fexp(bc); ko[i] = kf[i] * fexp(-bc); } }
#if !GLA_QK_OLD
            if (FULL) { v4u o; o.x = pk2(qo[0], qo[1]); o.y = pk2(qo[2], qo[3]); o.z = pk2(qo[4], qo[5]); o.w = pk2(qo[6], qo[7]); *(LAS v4u*)(QIN + kc * 72 + kd * 8) = o;
                        o.x = pk2(ko[0], ko[1]); o.y = pk2(ko[2], ko[3]); o.z = pk2(ko[4], ko[5]); o.w = pk2(ko[6], ko[7]); *(LAS v4u*)(KIN + kc * 72 + kd * 8) = o; }
#endif
        }
#if GLA_QK_OLD
        if (FULL) for (int idx = X.tid; idx < 64 * 48; idx += 512) { const int c = idx / 48, d = idx % 48;
            const float kk = bf2f(Z[(m0 + c) * INP + ZC_K + h * 48 + d]); const float bc = LGT[d * 65 + c];
            const float qq = bf2f(Z[(m0 + c) * INP + ZC_Q + h * 48 + d]);
            QIN[c * 72 + d] = f2bf(qq * 0.14433756729740643f * __expf(bc)); KIN[c * 72 + d] = f2bf(kk * __expf(-bc)); }
#endif
        if (FULL) {
#pragma unroll
            for (int i = 0; i < 3; ++i) { const int ti = X.wave + 8 * i; if (ti < 18) { const int dt = ti / 6, et = ti % 6;
                v2u o; o.x = pk2(Sacc[i][0], Sacc[i][1]); o.y = pk2(Sacc[i][2], Sacc[i][3]);
                *(LAS v2u*)(ST + (et * 16 + col) * 72 + dt * 16 + 4 * q) = o; } } }
        BSYNC();
        if (FULL) {
#pragma unroll
            for (int i2 = 0; i2 < 2; ++i2) { const int tl = X.wave + 8 * i2, ct = tl >> 2, jt = tl & 3;
                f32x4 acc = {0.f, 0.f, 0.f, 0.f};
                if (jt <= ct) {
#pragma unroll
                    for (int ks = 0; ks < 2; ++ks) { const bf16x8 av = *(const LAS bf16x8*)(QIN + (ct * 16 + col) * 72 + ks * 32 + 8 * q), bv = *(const LAS bf16x8*)(KIN + (jt * 16 + col) * 72 + ks * 32 + 8 * q);
                        acc = __builtin_amdgcn_mfma_f32_16x16x32_bf16(av, bv, acc, 0, 0, 0); } }
#pragma unroll
                for (int r = 0; r < 4; ++r) { const int c = ct * 16 + 4 * q + r, j = jt * 16 + col; SC[c * 72 + j] = (j <= c) ? f2bf(acc[r]) : (bf16)0; } }
        }
#pragma unroll
        for (int i = 0; i < 3; ++i) { const int ti = X.wave + 8 * i; if (ti < 18) { const int dt = ti / 6, et = ti % 6;
            f32x4 acc; const f32x4 bl4 = *(const LAS f32x4*)(BL + dt * 16 + 4 * q);
#pragma unroll
            for (int r = 0; r < 4; ++r) acc[r] = fexp(bl4[r]) * Sacc[i][r];
#pragma unroll
            for (int ks = 0; ks < 2; ++ks) { const bf16x8 av = *(const LAS bf16x8*)(KDT + (dt * 16 + col) * 72 + ks * 32 + 8 * q), bv = *(const LAS bf16x8*)(VT + (et * 16 + col) * 72 + ks * 32 + 8 * q);
                acc = __builtin_amdgcn_mfma_f32_16x16x32_bf16(av, bv, acc, 0, 0, 0); }
            Sacc[i] = acc; } }
        if (X.tid < 48) LS[X.tid] += BL[X.tid];
        if (FULL) {
            BSYNC();
#if GLA_OLD67
            for (int tl = X.wave; tl < 24; tl += 8) { const int ct = tl / 6, et = tl % 6;
                f32x4 acc = {0.f, 0.f, 0.f, 0.f};
#pragma unroll
                for (int ks = 0; ks < 2; ++ks) { const bf16x8 av = *(const LAS bf16x8*)(SC + (ct * 16 + col) * 72 + ks * 32 + 8 * q), bv = *(const LAS bf16x8*)(VT + (et * 16 + col) * 72 + ks * 32 + 8 * q);
                    acc = __builtin_amdgcn_mfma_f32_16x16x32_bf16(av, bv, acc, 0, 0, 0); }
#pragma unroll
                for (int ks = 0; ks < 2; ++ks) { const bf16x8 av = *(const LAS bf16x8*)(QIN + (ct * 16 + col) * 72 + ks * 32 + 8 * q), bv = *(const LAS bf16x8*)(ST + (et * 16 + col) * 72 + ks * 32 + 8 * q);
                    acc = __builtin_amdgcn_mfma_f32_16x16x32_bf16(av, bv, acc, 0, 0, 0); }
#pragma unroll
                for (int r = 0; r < 4; ++r) OB[(ct * 16 + 4 * q + r) * 100 + et * 16 + col] = acc[r]; }
            BSYNC();
            for (int i = 0; i < 8; ++i) { const int c = X.wave * 8 + i;
                const float o0 = OB[c * 100 + X.lane], o1 = (X.lane < 32) ? OB[c * 100 + 64 + X.lane] : 0.f;
                const float rstd = 1.0f / sqrtf(wave_sum(o0 * o0 + o1 * o1) * (1.0f / 96.0f) + EPS_);
                const bf16* zr = Z + (m0 + c) * INP + ZC_OG + h * 96; bf16* mr = MX + (m0 + c) * 1024 + 640 + h * 96;
                { const float og = bf2f(zr[X.lane]); mr[X.lane] = f2bf(o0 * rstd * AIN(I_GNG)[l * 384 + h * 96 + X.lane] * og * sigm(og)); }
                if (X.lane < 32) { const float og = bf2f(zr[64 + X.lane]); mr[64 + X.lane] = f2bf(o1 * rstd * AIN(I_GNG)[l * 384 + h * 96 + 64 + X.lane] * og * sigm(og)); } }
#else
            { const int ct = X.wave & 3, eh = X.wave >> 2; f32x4 ss = {0.f, 0.f, 0.f, 0.f};
                const bf16x8 s0 = *(const LAS bf16x8*)(SC + (ct * 16 + col) * 72 + 8 * q), s1 = *(const LAS bf16x8*)(SC + (ct * 16 + col) * 72 + 32 + 8 * q);
                const bf16x8 q0 = *(const LAS bf16x8*)(QIN + (ct * 16 + col) * 72 + 8 * q), q1 = *(const LAS bf16x8*)(QIN + (ct * 16 + col) * 72 + 32 + 8 * q);
#pragma unroll
                for (int i3 = 0; i3 < 3; ++i3) { const int et = eh * 3 + i3; f32x4 acc = {0.f, 0.f, 0.f, 0.f};
                    acc = __builtin_amdgcn_mfma_f32_16x16x32_bf16(s0, *(const LAS bf16x8*)(VT + (et * 16 + col) * 72 + 8 * q), acc, 0, 0, 0);
                    acc = __builtin_amdgcn_mfma_f32_16x16x32_bf16(s1, *(const LAS bf16x8*)(VT + (et * 16 + col) * 72 + 32 + 8 * q), acc, 0, 0, 0);
                    acc = __builtin_amdgcn_mfma_f32_16x16x32_bf16(q0, *(const LAS bf16x8*)(ST + (et * 16 + col) * 72 + 8 * q), acc, 0, 0, 0);
                    acc = __builtin_amdgcn_mfma_f32_16x16x32_bf16(q1, *(const LAS bf16x8*)(ST + (et * 16 + col) * 72 + 32 + 8 * q), acc, 0, 0, 0);
                    ss += acc * acc;
#pragma unroll
                    for (int r = 0; r < 4; ++r) OB[(ct * 16 + 4 * q + r) * 100 + et * 16 + col] = acc[r]; }
#pragma unroll
                for (int r = 0; r < 4; ++r) { float s = ss[r]; s += dpp_mov0<0xB1>(s); s += dpp_mov0<0x4E>(s); s += dpp_mov0<0x141>(s); s += dpp_mov0<0x140>(s); ss[r] = s; }
                if (col == 0) *(LAS f32x4*)(SSQ + eh * 64 + ct * 16 + 4 * q) = ss; }
            BSYNC();
            { const float rstd = 1.0f / sqrtf((SSQ[vc0] + SSQ[64 + vc0]) * (1.0f / 96.0f) + EPS_);
                const f32x4 oa = *(const LAS f32x4*)(OB + vc0 * 100 + ve0 * 8), ob = *(const LAS f32x4*)(OB + vc0 * 100 + ve0 * 8 + 4);
                const float g0 = lo_f(og0.x), g1 = hi_f(og0.x), g2 = lo_f(og0.y), g3 = hi_f(og0.y), g4 = lo_f(og0.z), g5 = hi_f(og0.z), g6 = lo_f(og0.w), g7 = hi_f(og0.w);
                v4u o; o.x = pk2(oa.x * rstd * gn0[0].x * g0 * sigm_fast(g0), oa.y * rstd * gn0[0].y * g1 * sigm_fast(g1)); o.y = pk2(oa.z * rstd * gn0[0].z * g2 * sigm_fast(g2), oa.w * rstd * gn0[0].w * g3 * sigm_fast(g3));
                o.z = pk2(ob.x * rstd * gn0[1].x * g4 * sigm_fast(g4), ob.y * rstd * gn0[1].y * g5 * sigm_fast(g5)); o.w = pk2(ob.z * rstd * gn0[1].z * g6 * sigm_fast(g6), ob.w * rstd * gn0[1].w * g7 * sigm_fast(g7));
                *(v4u*)(MX + (m0 + vc0) * 1024 + 640 + h * 96 + ve0 * 8) = o; }
            if (has1) { const float rstd = 1.0f / sqrtf((SSQ[vc1] + SSQ[64 + vc1]) * (1.0f / 96.0f) + EPS_);
                const f32x4 oa = *(const LAS f32x4*)(OB + vc1 * 100 + ve1 * 8), ob = *(const LAS f32x4*)(OB + vc1 * 100 + ve1 * 8 + 4);
                const float g0 = lo_f(og1.x), g1 = hi_f(og1.x), g2 = lo_f(og1.y), g3 = hi_f(og1.y), g4 = lo_f(og1.z), g5 = hi_f(og1.z), g6 = lo_f(og1.w), g7 = hi_f(og1.w);
                v4u o; o.x = pk2(oa.x * rstd * gn1[0].x * g0 * sigm_fast(g0), oa.y * rstd * gn1[0].y * g1 * sigm_fast(g1)); o.y = pk2(oa.z * rstd * gn1[0].z * g2 * sigm_fast(g2), oa.w * rstd * gn1[0].w * g3 * sigm_fast(g3));
                o.z = pk2(ob.x * rstd * gn1[1].x * g4 * sigm_fast(g4), ob.y * rstd * gn1[1].y * g5 * sigm_fast(g5)); o.w = pk2(ob.z * rstd * gn1[1].z * g6 * sigm_fast(g6), ob.w * rstd * gn1[1].w * g7 * sigm_fast(g7));
                *(v4u*)(MX + (m0 + vc1) * 1024 + 640 + h * 96 + ve1 * 8) = o; }
#endif
        }
        BSYNC();
    }
    if (!FULL) { float* ag = AGG + (size_t)u * GLA_AGG;
        if (X.tid < 48) ag[X.tid] = LS[X.tid];
#pragma unroll
        for (int i = 0; i < 3; ++i) { const int ti = X.wave + 8 * i; if (ti < 18) { const int dt = ti / 6, et = ti % 6;
#pragma unroll
            for (int r = 0; r < 4; ++r) ag[48 + (dt * 16 + 4 * q + r) * 96 + et * 16 + col] = Sacc[i][r]; } } }
    BSYNC();
}
constexpr int GOO_LG = 0, GOO_QIN = 12288, GOO_KIN = 21504, GOO_KDT = 30720, GOO_VT = 37632, GOO_SC = 51456, GOO_ST = 60672, GOO_OB = 74496, GOO_GL = 99328, GOO_BL = 103424, GOO_LS = 103680, GOO_WG = 103936;
template <bool FULL> __device__ __forceinline__ void gla_unit_old(const Args& a, const Ctx& X0, int l, int u) {
    UNIT_CTX(X0);
    const int b = u >> 6, h = (u >> 4) & 3, sc = u & 15;
    const bf16* Z = WSP(bf16, WS_A0); bf16* MX = WSP(bf16, WS_A1);
    float* AGG = MISCP(float, l, MO_GLA);
    LAS float* LG = (LAS float*)(X.lds + GOO_LG); LAS bf16* QIN = (LAS bf16*)(X.lds + GOO_QIN); LAS bf16* KIN = (LAS bf16*)(X.lds + GOO_KIN); LAS bf16* KDT = (LAS bf16*)(X.lds + GOO_KDT);
    LAS bf16* VT = (LAS bf16*)(X.lds + GOO_VT); LAS bf16* SC = (LAS bf16*)(X.lds + GOO_SC); LAS bf16* ST = (LAS bf16*)(X.lds + GOO_ST); LAS float* OB = (LAS float*)(X.lds + GOO_OB);
    LAS float* GL = (LAS float*)(X.lds + GOO_GL); LAS float* BL = (LAS float*)(X.lds + GOO_BL); LAS float* LS = (LAS float*)(X.lds + GOO_LS); LAS float* WG = (LAS float*)(X.lds + GOO_WG);
    const int col = X.lane & 15, q = X.lane >> 4;
    for (int i = X.tid; i < 16 * 48; i += 512) WG[i] = AIN(I_GWG)[(l * 16 + i / 48) * 192 + h * 48 + i % 48];
    if (X.tid < 48) LS[X.tid] = 0.f;
    if (FULL) { for (int i = X.tid; i < 64 * 16; i += 512) { const int r = i >> 4, cc = 48 + (i & 15); QIN[r * 72 + cc] = 0; KIN[r * 72 + cc] = 0; }
                for (int i = X.tid; i < 96 * 16; i += 512) { const int r = i >> 4, cc = 48 + (i & 15); ST[r * 72 + cc] = 0; } }
    f32x4 Sacc[3];
#pragma unroll
    for (int i = 0; i < 3; ++i) Sacc[i] = (f32x4){0.f, 0.f, 0.f, 0.f};
    if (FULL) {
        for (int s2 = 0; s2 < sc; ++s2) { const float* ag = AGG + (size_t)((b * 4 + h) * 16 + s2) * GLA_AGG;
#pragma unroll
            for (int i = 0; i < 3; ++i) { const int ti = X.wave + 8 * i; if (ti < 18) { const int dt = ti / 6, et = ti % 6;
#pragma unroll
                for (int r = 0; r < 4; ++r) { const int d = dt * 16 + 4 * q + r; Sacc[i][r] = __expf(ag[d]) * Sacc[i][r] + ag[48 + d * 96 + et * 16 + col]; } } } }
    }
    BSYNC();
    for (int ch = 0; ch < 4; ++ch) {
        const int t0 = sc * 256 + ch * 64; const size_t m0 = (size_t)b * S_ + t0;
        { const int c = X.tid >> 3, r2 = (X.tid & 7) * 2; const unsigned w = *(const unsigned*)(Z + (m0 + c) * INP + ZC_GLR + r2); GL[c * 16 + r2] = lo_f(w); GL[c * 16 + r2 + 1] = hi_f(w); }
        for (int idx = X.tid; idx < 64 * 48; idx += 512) { const int c = idx / 48, e2 = idx % 48;
            const unsigned w = *(const unsigned*)(Z + (m0 + c) * INP + ZC_V + h * 96 + 2 * e2);
            VT[(2 * e2) * 72 + c] = (bf16)(w & 0xffffu); VT[(2 * e2 + 1) * 72 + c] = (bf16)(w >> 16); }
        BSYNC();
        for (int o = X.tid; o < 64 * 48; o += 512) { const int c = o / 48, d = o % 48; float s = AIN(I_GBG)[l * 192 + h * 48 + d];
#pragma unroll
            for (int r = 0; r < 16; ++r) s += GL[c * 16 + r] * WG[r * 48 + d];
            const float ls = fminf(s, 0.f) - log1pf(__expf(-fabsf(s)));
            LG[c * 48 + d] = ls * 0.0625f; }
        BSYNC();
        if (X.tid < 48) { float s = 0.f; for (int c = 0; c < 64; ++c) { s += LG[c * 48 + X.tid]; LG[c * 48 + X.tid] = s; } BL[X.tid] = s; }
        BSYNC();
        for (int idx = X.tid; idx < 64 * 48; idx += 512) { const int c = idx / 48, d = idx % 48;
            const float kk = bf2f(Z[(m0 + c) * INP + ZC_K + h * 48 + d]); const float bc = LG[c * 48 + d], bl = BL[d];
            KDT[d * 72 + c] = f2bf(kk * __expf(bl - bc));
            if (FULL) { const float qq = bf2f(Z[(m0 + c) * INP + ZC_Q + h * 48 + d]);
                QIN[c * 72 + d] = f2bf(qq * 0.14433756729740643f * __expf(bc)); KIN[c * 72 + d] = f2bf(kk * __expf(-bc)); } }
        if (FULL) {
#pragma unroll
            for (int i = 0; i < 3; ++i) { const int ti = X.wave + 8 * i; if (ti < 18) { const int dt = ti / 6, et = ti % 6;
                v2u o; o.x = pk2(Sacc[i][0], Sacc[i][1]); o.y = pk2(Sacc[i][2], Sacc[i][3]);
                *(LAS v2u*)(ST + (et * 16 + col) * 72 + dt * 16 + 4 * q) = o; } } }
        BSYNC();
        if (FULL) {
            for (int tl = X.wave; tl < 16; tl += 8) { const int ct = tl >> 2, jt = tl & 3;
                f32x4 acc = {0.f, 0.f, 0.f, 0.f};
                if (jt <= ct) {
#pragma unroll
                    for (int ks = 0; ks < 2; ++ks) { const bf16x8 av = *(const LAS bf16x8*)(QIN + (ct * 16 + col) * 72 + ks * 32 + 8 * q), bv = *(const LAS bf16x8*)(KIN + (jt * 16 + col) * 72 + ks * 32 + 8 * q);
                        acc = __builtin_amdgcn_mfma_f32_16x16x32_bf16(av, bv, acc, 0, 0, 0); } }
#pragma unroll
                for (int r = 0; r < 4; ++r) { const int c = ct * 16 + 4 * q + r, j = jt * 16 + col; SC[c * 72 + j] = (j <= c) ? f2bf(acc[r]) : (bf16)0; } }
        }
#pragma unroll
        for (int i = 0; i < 3; ++i) { const int ti = X.wave + 8 * i; if (ti < 18) { const int dt = ti / 6, et = ti % 6;
            f32x4 acc;
#pragma unroll
            for (int r = 0; r < 4; ++r) acc[r] = __expf(BL[dt * 16 + 4 * q + r]) * Sacc[i][r];
#pragma unroll
            for (int ks = 0; ks < 2; ++ks) { const bf16x8 av = *(const LAS bf16x8*)(KDT + (dt * 16 + col) * 72 + ks * 32 + 8 * q), bv = *(const LAS bf16x8*)(VT + (et * 16 + col) * 72 + ks * 32 + 8 * q);
                acc = __builtin_amdgcn_mfma_f32_16x16x32_bf16(av, bv, acc, 0, 0, 0); }
            Sacc[i] = acc; } }
        if (X.tid < 48) LS[X.tid] += BL[X.tid];
        if (FULL) {
            BSYNC();
            for (int tl = X.wave; tl < 24; tl += 8) { const int ct = tl / 6, et = tl % 6;
                f32x4 acc = {0.f, 0.f, 0.f, 0.f};
#pragma unroll
                for (int ks = 0; ks < 2; ++ks) { const bf16x8 av = *(const LAS bf16x8*)(SC + (ct * 16 + col) * 72 + ks * 32 + 8 * q), bv = *(const LAS bf16x8*)(VT + (et * 16 + col) * 72 + ks * 32 + 8 * q);
                    acc = __builtin_amdgcn_mfma_f32_16x16x32_bf16(av, bv, acc, 0, 0, 0); }
#pragma unroll
                for (int ks = 0; ks < 2; ++ks) { const bf16x8 av = *(const LAS bf16x8*)(QIN + (ct * 16 + col) * 72 + ks * 32 + 8 * q), bv = *(const LAS bf16x8*)(ST + (et * 16 + col) * 72 + ks * 32 + 8 * q);
                    acc = __builtin_amdgcn_mfma_f32_16x16x32_bf16(av, bv, acc, 0, 0, 0); }
#pragma unroll
                for (int r = 0; r < 4; ++r) OB[(ct * 16 + 4 * q + r) * 97 + et * 16 + col] = acc[r]; }
            BSYNC();
            for (int i = 0; i < 8; ++i) { const int c = X.wave * 8 + i;
                const float o0 = OB[c * 97 + X.lane], o1 = (X.lane < 32) ? OB[c * 97 + 64 + X.lane] : 0.f;
                const float rstd = 1.0f / sqrtf(wave_sum(o0 * o0 + o1 * o1) * (1.0f / 96.0f) + EPS_);
                const bf16* zr = Z + (m0 + c) * INP + ZC_OG + h * 96; bf16* mr = MX + (m0 + c) * 1024 + 640 + h * 96;
                { const float og = bf2f(zr[X.lane]); mr[X.lane] = f2bf(o0 * rstd * AIN(I_GNG)[l * 384 + h * 96 + X.lane] * og * sigm(og)); }
                if (X.lane < 32) { const float og = bf2f(zr[64 + X.lane]); mr[64 + X.lane] = f2bf(o1 * rstd * AIN(I_GNG)[l * 384 + h * 96 + 64 + X.lane] * og * sigm(og)); } }
        }
        BSYNC();
    }
    if (!FULL) { float* ag = AGG + (size_t)u * GLA_AGG;
        if (X.tid < 48) ag[X.tid] = LS[X.tid];
#pragma unroll
        for (int i = 0; i < 3; ++i) { const int ti = X.wave + 8 * i; if (ti < 18) { const int dt = ti / 6, et = ti % 6;
#pragma unroll
            for (int r = 0; r < 4; ++r) ag[48 + (dt * 16 + 4 * q + r) * 96 + et * 16 + col] = Sacc[i][r]; } } }
    BSYNC();
}
__device__ __forceinline__ void p5a_unit(const Args& a, const Ctx& X0, int l, int u) {
    UNIT_CTX(X0);
    const size_t m0 = (size_t)u * 64; const int b = u >> 6;
    bf16* H = WSP(bf16, WS_A2);
    LAS float* WT = (LAS float*)X.lds;
    LAS float* LOG = (LAS float*)(X.lds + 81920);
#pragma unroll
    for (int it = 0; it < 10; ++it) { const int i = X.tid + 512 * it, grp = i >> 10, k = i & 1023;
        const f32x4 w = (grp == 0) ? *(const f32x4*)(AIN(I_WRG) + (size_t)l * 4096 + k * 4) : *(const f32x4*)(AIN(I_WRE) + (size_t)l * 16384 + (grp - 1) * 4096 + k * 4);
        WT[(grp * 4 + 0) * 1024 + k] = w.x; WT[(grp * 4 + 1) * 1024 + k] = w.y; WT[(grp * 4 + 2) * 1024 + k] = w.z; WT[(grp * 4 + 3) * 1024 + k] = w.w; }
    BSYNC();
    const float* md = MODP(a) + (size_t)(l * 4 + b) * 6144;
    const float biasv = (X.lane < 4) ? AIN(I_BRG)[l * 4 + X.lane] : (X.lane < 20) ? AIN(I_BRE)[l * 16 + (X.lane - 4)] : 0.f;
    for (int grp = 0; grp < 2; ++grp) {
        f32x4 hv[4][4];
#pragma unroll
        for (int r = 0; r < 4; ++r)
#pragma unroll
            for (int j = 0; j < 4; ++j) hv[r][j] = ((const f32x4*)(a.out + (m0 + X.wave * 8 + grp * 4 + r) * 1024))[X.lane + 64 * j];
#pragma unroll
        for (int r = 0; r < 4; ++r) { float ss = 0.f;
#pragma unroll
            for (int j = 0; j < 4; ++j) ss += (hv[r][j].x * hv[r][j].x + hv[r][j].y * hv[r][j].y) + (hv[r][j].z * hv[r][j].z + hv[r][j].w * hv[r][j].w);
            const float rstd = 1.0f / sqrtf(wave_sum(ss) * (1.0f / 1024.0f) + EPS_); const size_t m = m0 + X.wave * 8 + grp * 4 + r;
#pragma unroll
            for (int j = 0; j < 4; ++j) { const f32x4 g = ((const f32x4*)(AIN(I_GFFN) + l * 1024))[X.lane + 64 * j], sh = ((const f32x4*)(md + 3 * 1024))[X.lane + 64 * j], sc = ((const f32x4*)(md + 4 * 1024))[X.lane + 64 * j];
                const f32x4 h = hv[r][j] * rstd * g * (sc + 1.0f) + sh; hv[r][j] = h;
                v2u o; o.x = pk2(h.x, h.y); o.y = pk2(h.z, h.w); ((v2u*)(H + m * 1024))[X.lane + 64 * j] = o; } }
        for (int jo = 0; jo < 20; ++jo) {
            f32x4 wt[4];
#pragma unroll
            for (int j = 0; j < 4; ++j) wt[j] = *(const LAS f32x4*)(WT + jo * 1024 + (X.lane + 64 * j) * 4);
            const float bias = __builtin_bit_cast(float, __builtin_amdgcn_readlane(__builtin_bit_cast(int, biasv), jo));
#pragma unroll
            for (int r = 0; r < 4; ++r) { float s = 0.f;
#pragma unroll
                for (int j = 0; j < 4; ++j) s += (hv[r][j].x * wt[j].x + hv[r][j].y * wt[j].y) + (hv[r][j].z * wt[j].z + hv[r][j].w * wt[j].w);
                s = wave_sum(s);
                if (X.lane == 0) LOG[(X.wave * 8 + grp * 4 + r) * 20 + jo] = s + bias; }
        }
    }
    BSYNC();
    if (X.wave == 0) {
        const int row = X.lane; const LAS float* lg = LOG + row * 20;
        int gs = 0; float gm = lg[0];
#pragma unroll
        for (int i = 1; i < 4; ++i) if (lg[i] > gm) { gm = lg[i]; gs = i; }
        float den = 0.f;
#pragma unroll
        for (int i = 0; i < 4; ++i) den += __expf(lg[i] - gm);
        const float psel = 1.0f / den;
        const float e0 = lg[4 + gs * 4], e1 = lg[5 + gs * 4], e2 = lg[6 + gs * 4], e3 = lg[7 + gs * 4];
        int i0 = 0; float v0 = e0;
        if (e1 > v0) { v0 = e1; i0 = 1; } if (e2 > v0) { v0 = e2; i0 = 2; } if (e3 > v0) { v0 = e3; i0 = 3; }
        int i1 = -1; float v1 = 0.f;
        if (i0 != 0) { v1 = e0; i1 = 0; }
        if (i0 != 1 && (i1 < 0 || e1 > v1)) { v1 = e1; i1 = 1; }
        if (i0 != 2 && (i1 < 0 || e2 > v1)) { v1 = e2; i1 = 2; }
        if (i0 != 3 && (i1 < 0 || e3 > v1)) { v1 = e3; i1 = 3; }
        const float tt = __expf(v1 - v0), w0 = psel / (1.0f + tt), w1 = psel * tt / (1.0f + tt);
        const int E0 = gs * 4 + i0, E1 = gs * 4 + i1;
        const unsigned long long below = (1ull << row) - 1ull;
        int rank0 = 0, rank1 = 0, mycnt = 0;
        for (int e = 0; e < 16; ++e) { const unsigned long long b0 = __ballot(E0 == e), b1 = __ballot(E1 == e);
            const int rk = __popcll(b0 & below) + __popcll(b1 & below);
            if (E0 == e) rank0 = rk; if (E1 == e) rank1 = rk;
            if (row == e) mycnt = __popcll(b0) + __popcll(b1); }
        const size_t m = m0 + row;
        MISCP(int, l, MO_TOKE)[2 * m] = E0; MISCP(int, l, MO_TOKE)[2 * m + 1] = E1;
        MISCP(float, l, MO_TOKW)[2 * m] = w0; MISCP(float, l, MO_TOKW)[2 * m + 1] = w1;
        MISCP(int, l, MO_TOKR)[2 * m] = rank0; MISCP(int, l, MO_TOKR)[2 * m + 1] = rank1;
        if (row < 16) MISCP(int, l, MO_BCNT)[u * 16 + row] = mycnt;
    }
    BSYNC();
}
__device__ __forceinline__ void p5b_phase(const Args& a, const Ctx& X, int l) {
    const int zo = 0;
    const int* BC = MISCP(int, l, MO_BCNT);
    LAS int* PART = (LAS int*)X.lds;
    LAS int* TOT = PART + 512; LAS int* OFF = TOT + 16; LAS int* PRE = OFF + 16; LAS int* POSL = PRE + 32;
    { const int e = X.tid & 15, part = X.tid >> 4; int s = 0;
#pragma unroll
      for (int i = 0; i < 8; ++i) s += __hip_atomic_load(BC + (part * 8 + i) * 16 + e, RLX_AGENT);
      PART[part * 16 + e] = s; }
    BSYNC();
    if (X.tid < 16) { int s = 0; for (int p = 0; p < 32; ++p) s += PART[p * 16 + X.tid]; TOT[X.tid] = s; }
    BSYNC();
    if (X.tid == 0) { int p = 0; for (int e = 0; e < 16; ++e) { PRE[e] = p; p += (TOT[e] + 255) >> 8; } PRE[16] = p;
        if (blockIdx.x == 0) { int* gp = MISCP(int, l, MO_PRE); for (int e = 0; e < 17; ++e) gp[e] = PRE[e]; } }
    BSYNC();
    const bf16* H = WSP(bf16, WS_A2); bf16* HS = WSP(bf16, WS_A0);
    for (int u = X.vcu; u < 256; u += X.G) {
        if (X.tid < 16) { int s = 0; const int pu = u >> 3; for (int p = 0; p < pu; ++p) s += PART[p * 16 + X.tid];
            for (int uu = pu * 8; uu < u; ++uu) s += __hip_atomic_load(BC + uu * 16 + X.tid, RLX_AGENT);
            OFF[X.tid] = s; }
        BSYNC();
        if (X.tid < 128) { const size_t m = (size_t)u * 64 + (X.tid >> 1); const int k = X.tid & 1;
            const int E = MISCP(int, l, MO_TOKE)[2 * m + k];
            const int pos = PRE[E] * 256 + OFF[E] + MISCP(int, l, MO_TOKR)[2 * m + k];
            MISCP(int, l, MO_TOKP)[2 * m + k] = pos; MISCP(float, l, MO_ROWW)[pos] = MISCP(float, l, MO_TOKW)[2 * m + k]; POSL[X.tid] = pos; }
        BSYNC();
        for (int i = 0; i < 16; ++i) { const int ent = X.wave * 16 + i; const size_t m = (size_t)u * 64 + (ent >> 1);
            const v4u* src = (const v4u*)(H + m * 1024); v4u* dst = (v4u*)(HS + (size_t)POSL[ent] * 1024);
            const v4u x0 = src[X.lane], x1 = src[X.lane + 64]; dst[X.lane] = x0; dst[X.lane + 64] = x1; }
        BSYNC();
    }
    for (int e = X.vcu; e < 16; e += X.G) { const int r0 = PRE[e] * 256 + TOT[e], r1 = PRE[e + 1] * 256; for (int r = r0 + X.tid; r < r1; r += 512) MISCP(float, l, MO_ROWW)[r] = 0.f; }
}

__device__ __forceinline__ float dot_bf16(const bf16* x, const bf16* w, int K) {
    float s = 0.f;
    for (int k = 0; k < K; k += 8) { const v4u xv = *(const v4u*)(x + k), wv = *(const v4u*)(w + k);
        s += lo_f(xv.x) * lo_f(wv.x) + hi_f(xv.x) * hi_f(wv.x) + lo_f(xv.y) * lo_f(wv.y) + hi_f(xv.y) * hi_f(wv.y) + lo_f(xv.z) * lo_f(wv.z) + hi_f(xv.z) * hi_f(wv.z) + lo_f(xv.w) * lo_f(wv.w) + hi_f(xv.w) * hi_f(wv.w); }
    return s;
}
template <int KIND> __device__ __forceinline__ void naive_gemm(const Args& a, const Ctx& X, int l) {
    const int zo = 0;
    const size_t gt = (size_t)X.vcu * 512 + X.tid, NT = (size_t)X.G * 512;
    if (KIND == 0) { const bf16* A = WSP(bf16, WS_A2); const bf16* Bt = WSP(bf16, WS_WIN) + (size_t)l * INP * 1024; bf16* Zo = WSP(bf16, WS_A0);
        for (size_t i = gt; i < (size_t)T_ * INP; i += NT) { const size_t r = i / INP, c = i % INP; Zo[i] = f2bf(dot_bf16(A + r * 1024, Bt + c * 1024, 1024)); } }
    if (KIND == 1) { const bf16* A = WSP(bf16, WS_A1); const bf16* Bt = WSP(bf16, WS_WOUT) + (size_t)l * 1048576; const float* xin = (l == 0) ? a.in[I_X] : a.out;
        for (size_t i = gt; i < (size_t)T_ * 1024; i += NT) { const size_t r = i >> 10, c = i & 1023; const float g = MODP(a)[((size_t)(l * 4 + (r >> 12)) * 6 + 2) * 1024 + c];
            a.out[i] = xin[i] + g * dot_bf16(A + r * 1024, Bt + c * 1024, 1024); } }
    if (KIND == 2 || KIND == 3) {
        const int* gp = MISCP(int, l, MO_PRE); const int nrows = gp[16] * 256;
        if (KIND == 2) { const bf16* A = WSP(bf16, WS_A0); const bf16* Bt = WSP(bf16, WS_WGU) + (size_t)l * 16 * 1048576; bf16* Ho = WSP(bf16, WS_A1); const float* rw = MISCP(float, l, MO_ROWW);
            for (size_t i = gt; i < (size_t)nrows * 512; i += NT) { const size_t r = i >> 9, f = i & 511; const int mt = (int)(r >> 8); int e = 0; for (int k = 1; k < 16; ++k) e += (mt >= gp[k]) ? 1 : 0;
                const bf16* W = Bt + (size_t)e * 1048576 + ((f >> 7) * 256 + (f & 127)) * 1024;
                const float g = dot_bf16(A + r * 1024, W, 1024), up = dot_bf16(A + r * 1024, W + 128 * 1024, 1024);
                Ho[i] = f2bf(g * sigm(g) * up * rw[r]); } }
        else { const bf16* A = WSP(bf16, WS_A1); const bf16* Bt = WSP(bf16, WS_WD) + (size_t)l * 16 * 524288; bf16* Yo = WSP(bf16, WS_A0);
            for (size_t i = gt; i < (size_t)nrows * 1024; i += NT) { const size_t r = i >> 10, c = i & 1023; const int mt = (int)(r >> 8); int e = 0; for (int k = 1; k < 16; ++k) e += (mt >= gp[k]) ? 1 : 0;
                Yo[i] = f2bf(dot_bf16(A + r * 512, Bt + (size_t)e * 524288 + c * 512, 512)); } }
    }
}
constexpr int N_PHASES = 20;
#if MK_PER_PHASE
#define SEAM(k) do { } while (0)
#else
#define SEAM(k) do { if ((k) + 1 < hi) xcd_barrier(bar); } while (0)
#endif
#ifndef PH_MASK
#define PH_MASK 0xFFFFF
#endif
#define IN(k) (((PH_MASK >> (k)) & 1) && lo <= (k) && (k) < hi)
#ifndef REP_PHASE
#define REP_PHASE -1
#define REP_N 1
#endif
#ifndef GLA_A
#define GLA_A gla_unit
#endif
#ifndef GLA_C
#define GLA_C gla_unit
#endif
#ifndef SUBREP_ID
#define SUBREP_ID 0
#define SUBREP_N 1
#endif
#define SUBREP(i) ((L == 0 && (i) == SUBREP_ID) ? SUBREP_N : 1)
#define REPS(k) (((k) == REP_PHASE) ? REP_N : 1)
template <int L> __device__ __forceinline__ void layer_program(const Args& a, LAS unsigned char* lds, const XcdBarrier& bar, const int lo, const int hi) {
    constexpr int l = L, base = 1 + 9 * L; const int zo = 0;
    if (IN(base + 0)) for (int rep = 0; rep < REPS(base + 0); ++rep) { const Ctx X = mkctx(lds); if (L == 0) row_phase<0>(a, X, 0); else row_phase<1>(a, X, l); SEAM(base + 0); }
    if (IN(base + 1)) for (int rep = 0; rep < REPS(base + 1); ++rep) { const Ctx X = mkctx(lds);
#if NAIVE_GEMM_MASK & 1
        naive_gemm<0>(a, X, l);
#else
        pg8::Gemm g{WSP(bf16, WS_A2), WSP(bf16, WS_WIN) + (size_t)l * INP * 1024, T_, INP, 1024}; pg8::StaticOrder S; S.init(T_, INP, X.G, X.bx);
        pg8::EpiBf16<0> E{WSP(bf16, WS_A0), INP, nullptr, 0, 0, 1.f};
        pg8::gemm_phase<pg8::EpiBf16<0>, pg8::StaticOrder, true, true>(X.lds, g, S, E);
#endif
        SEAM(base + 1); }
    if (IN(base + 2)) for (int rep = 0; rep < REPS(base + 2); ++rep) { const Ctx X = mkctx(lds); for (int u = X.vcu; u < 256; u += X.G) { for (int r2 = 0; r2 < SUBREP(1); ++r2) { conv_unit(a, X, l, u); BSYNC(); } for (int r2 = 0; r2 < SUBREP(2); ++r2) { lru_unit<false>(a, X, l, u); BSYNC(); } for (int r2 = 0; r2 < SUBREP(3); ++r2) GLA_A<false>(a, X, l, u); } SEAM(base + 2); }
    if (IN(base + 3)) for (int rep = 0; rep < REPS(base + 3); ++rep) { const Ctx X = mkctx(lds); for (int u = X.vcu; u < 256; u += X.G) { for (int r2 = 0; r2 < SUBREP(4); ++r2) { lru_unit<true>(a, X, l, u); BSYNC(); } for (int r2 = 0; r2 < SUBREP(5); ++r2) GLA_C<true>(a, X, l, u); } SEAM(base + 3); }
    if (IN(base + 4)) for (int rep = 0; rep < REPS(base + 4); ++rep) { const Ctx X = mkctx(lds);
#if NAIVE_GEMM_MASK & 2
        naive_gemm<1>(a, X, l);
#else
        pg8::Gemm g{WSP(bf16, WS_A1), WSP(bf16, WS_WOUT) + (size_t)l * 1048576, T_, 1024, 1024}; pg8::StaticOrder S; S.init(T_, 1024, X.G, X.bx);
        pg8::EpiResid E{(l == 0) ? a.in[I_X] : a.out, a.out, MODP(a) + ((size_t)(l * 4) * 6 + 2) * 1024};
        pg8::gemm_phase<pg8::EpiResid, pg8::StaticOrder, true, true>(X.lds, g, S, E);
#endif
        SEAM(base + 4); }
    if (IN(base + 5)) for (int rep = 0; rep < REPS(base + 5); ++rep) { const Ctx X = mkctx(lds); for (int u = X.vcu; u < 256; u += X.G) p5a_unit(a, X, l, u); SEAM(base + 5); }
    if (IN(base + 6)) for (int rep = 0; rep < REPS(base + 6); ++rep) { const Ctx X = mkctx(lds); p5b_phase(a, X, l); SEAM(base + 6); }
    if (IN(base + 7)) for (int rep = 0; rep < REPS(base + 7); ++rep) { const Ctx X = mkctx(lds);
#if NAIVE_GEMM_MASK & 4
        naive_gemm<2>(a, X, l);
#else
        const int* gp = MISCP(int, l, MO_PRE);
        pg8::GroupedOrder S;
#pragma unroll
        for (int e = 0; e < 17; ++e) S.pre[e] = __builtin_amdgcn_readfirstlane(__hip_atomic_load(gp + e, RLX_AGENT));
        S.nwg = S.pre[16] * 4; S.G = X.G; S.c = X.bx;
        pg8::Gemm g{WSP(bf16, WS_A0), WSP(bf16, WS_WGU) + (size_t)l * 16 * 1048576, NROWS_PAD, 16384, 1024};
        pg8::EpiHid E{WSP(bf16, WS_A1), MISCP(float, l, MO_ROWW)};
        pg8::gemm_phase<pg8::EpiHid, pg8::GroupedOrder, true, true>(X.lds, g, S, E);
#endif
        SEAM(base + 7); }
    if (IN(base + 8)) for (int rep = 0; rep < REPS(base + 8); ++rep) { const Ctx X = mkctx(lds);
#if NAIVE_GEMM_MASK & 8
        naive_gemm<3>(a, X, l);
#else
        const int* gp = MISCP(int, l, MO_PRE);
        pg8::GroupedOrder S;
#pragma unroll
        for (int e = 0; e < 17; ++e) S.pre[e] = __builtin_amdgcn_readfirstlane(__hip_atomic_load(gp + e, RLX_AGENT));
        S.nwg = S.pre[16] * 4; S.G = X.G; S.c = X.bx;
        pg8::Gemm g{WSP(bf16, WS_A1), WSP(bf16, WS_WD) + (size_t)l * 16 * 524288, NROWS_PAD, 16384, 512};
        pg8::EpiY E{WSP(bf16, WS_A0)};
        pg8::gemm_phase<pg8::EpiY, pg8::GroupedOrder, true, true>(X.lds, g, S, E);
#endif
        SEAM(base + 8); }
}
__global__ void __launch_bounds__(NWAVES * 64, 2) mk_fwd(Args a) {
    extern __shared__ __attribute__((aligned(16))) unsigned char lds_raw[];
    LAS unsigned char* lds = (LAS unsigned char*)lds_raw;
    volatile LAS unsigned* MISC = (volatile LAS unsigned*)(lds + MISC_OFF);
    for (int u = threadIdx.x; u < (LDS_BYTES - LDSCTL_OFF) / 4; u += NWAVES * 64) ((LAS unsigned*)(lds + LDSCTL_OFF))[u] = 0u;
    __syncthreads();
    gu32* ctl = (gu32*)(a.ws + WS_CTL);
    XcdBarrier bar; bar.bar = (unsigned*)(ctl + CW_BAR); bar.x = 0; bar.st = nullptr;
#if !MK_PER_PHASE
    bar = xcd_barrier_post((unsigned*)(ctl + CW_BAR), MISC + 8);
#endif
    const int lo = a.ph_lo, hi = a.ph_hi;
    if (IN(0)) for (int rep = 0; rep < REPS(0); ++rep) { const Ctx X = mkctx(lds); p0_prologue(a, X); SEAM(0); }
    layer_program<0>(a, lds, bar, lo, hi);
    layer_program<1>(a, lds, bar, lo, hi);
    if (IN(N_PHASES - 1)) { const Ctx X = mkctx(lds); row_phase<2>(a, X, 2); }
}
#undef IN

extern "C" void kernel_launch(void* const* d_in, const int* in_sizes, int n_in, void* d_out, int out_size, void* d_ws, size_t ws_size, hipStream_t stream) {
    static int grid = 0;
    if (grid == 0) {
        if (n_in != 30 || in_sizes[0] != T_ * D_ || out_size != T_ * D_ || ws_size < WS_END) { fprintf(stderr, "kernel_launch: unexpected shapes (n_in %d, in0 %d, out %d, ws %zu); nothing launched\n", n_in, n_in > 0 ? in_sizes[0] : -1, out_size, ws_size); grid = -1; return; }
        int dev = 0, cus = 0, per_cu = 0;
        if (hipGetDevice(&dev) != hipSuccess || hipDeviceGetAttribute(&cus, hipDeviceAttributeMultiprocessorCount, dev) != hipSuccess) { fprintf(stderr, "kernel_launch: device query failed\n"); grid = -1; return; }
        if (hipFuncSetAttribute((const void*)mk_fwd, hipFuncAttributeMaxDynamicSharedMemorySize, LDS_BYTES) != hipSuccess) { fprintf(stderr, "kernel_launch: hipFuncSetAttribute failed\n"); grid = -1; return; }
        if (hipOccupancyMaxActiveBlocksPerMultiprocessor(&per_cu, (const void*)mk_fwd, NWAVES * 64, LDS_BYTES) != hipSuccess || per_cu < 1) { fprintf(stderr, "kernel_launch: occupancy query says %d blocks per CU\n", per_cu); per_cu = 1; }
        (void)hipGetLastError();
        grid = cus;
        if (grid > 256) grid = 256;
    }
    if (grid < 0) return;
    (void)hipMemsetAsync((char*)d_ws + WS_CTL, 0, CTL_ZERO_BYTES, stream);
    Args a{};
    for (int i = 0; i < 30; ++i) a.in[i] = (const float*)d_in[i];
    a.out = (float*)d_out; a.ws = (unsigned char*)d_ws;
#if MK_PER_PHASE
    for (int ph = 0; ph < N_PHASES; ++ph) { a.ph_lo = ph; a.ph_hi = ph + 1; a.li = ph; hipLaunchKernelGGL(mk_fwd, dim3(grid), dim3(NWAVES * 64), LDS_BYTES, stream, a); }
#else
    a.ph_lo = 0; a.ph_hi = N_PHASES; a.li = 0;
    hipLaunchKernelGGL(mk_fwd, dim3(grid), dim3(NWAVES * 64), LDS_BYTES, stream, a);
#endif
}
```
